# Optimizing an MI355X kernel written in HIP

```python
import math
import jax
import jax.numpy as jnp
from jax import lax
import numpy as np

D_MODEL = 1024
BATCH = 16
SEQ = 2048
DEPTH = 1
DEC_BATCH = 32
DEC_SEQ = 1
PAST_LEN = 16384
PAGE_SIZE = 128

A_GROUPS = ((128, 1), (512, 4), (2048, 16))
N_A_GROUPS = len(A_GROUPS)
A_HEADS = 8
A_HEAD_DIM = 64
A_ROT_DIM = A_HEAD_DIM // 4
A_BAND = 128
A_SCALE = A_HEAD_DIM ** -0.5
ROPE_THETA = 500000.0
R_HEADS = 4
R_QK_DIM = D_MODEL // R_HEADS
R_V_DIM = 2 * R_QK_DIM
R_CHUNK = 128
R_THETA = 10000.0
D_FF = ((8 * D_MODEL // 3 + 127) // 128) * 128
EPS = 1e-6
NEG = -1e30
A_QKV_W = N_A_GROUPS * A_HEADS * A_HEAD_DIM
R_QK_W = R_HEADS * R_QK_DIM
R_V_W = R_HEADS * R_V_DIM
SPLIT_SIZES = (A_QKV_W, A_QKV_W, A_QKV_W, R_QK_W, R_QK_W, R_V_W, R_V_W, D_MODEL, D_MODEL)
SPLIT_POINTS = tuple(sum(SPLIT_SIZES[:i + 1]) for i in range(len(SPLIT_SIZES) - 1))
D_IN = sum(SPLIT_SIZES)

kernel_name = 'hybrid_dilated_retention_macaron_step'


def _rmsnorm(x, g):
    xf = x.astype(jnp.float32)
    y = xf * lax.rsqrt(jnp.mean(xf * xf, axis=-1, keepdims=True) + EPS)
    return (y * g.astype(jnp.float32)).astype(x.dtype)


def _rms_plain(x):
    xf = x.astype(jnp.float32)
    return xf * lax.rsqrt(jnp.mean(xf * xf, axis=-1, keepdims=True) + EPS)


def _half_ffn(x, g, w_in, w_out):
    h = _rmsnorm(x, g)
    a, b = jnp.split(h @ w_in, 2, axis=-1)
    return x + (0.5 * ((jax.nn.silu(a) * b) @ w_out)).astype(x.dtype)


def _partial_rope(x, pos):
    half = A_ROT_DIM // 2
    inv = ROPE_THETA ** (-jnp.arange(half, dtype=jnp.float32) / half)
    ang = pos.astype(jnp.float32)[:, None] * inv[None, :]
    cos = jnp.cos(ang)[:, None, :]
    sin = jnp.sin(ang)[:, None, :]
    xf = x.astype(jnp.float32)
    x1 = xf[..., :half]
    x2 = xf[..., half:A_ROT_DIM]
    out = jnp.concatenate([x1 * cos - x2 * sin, x2 * cos + x1 * sin, xf[..., A_ROT_DIM:]], axis=-1)
    return out.astype(x.dtype)


def _retention_rotary(x, pos):
    half = x.shape[-1] // 2
    inv = 1.0 / (R_THETA ** jnp.linspace(0.0, 1.0, half, dtype=jnp.float32))
    ang = pos.astype(jnp.float32)[:, None] * inv[None, :]
    cos = jnp.cos(ang)[:, None, :]
    sin = jnp.sin(ang)[:, None, :]
    xf = x.astype(jnp.float32).reshape(x.shape[:-1] + (half, 2))
    xe, xo = xf[..., 0], xf[..., 1]
    out = jnp.stack([xe * cos - xo * sin, xo * cos + xe * sin], axis=-1).reshape(x.shape)
    return out.astype(x.dtype)


def _dilated_prompt(q, k, v, dil):
    B, S, H, E = q.shape
    L = S // dil
    N = B * dil
    nb = -(-L // A_BAND)
    Lp = nb * A_BAND

    def fold(t):
        return t.reshape(B, L, dil, H, E).transpose(0, 2, 1, 3, 4).reshape(N, L, H, E)

    def band(t):
        tp = jnp.pad(t, ((0, 0), (A_BAND, Lp - L), (0, 0), (0, 0))).reshape(N, nb + 1, A_BAND, H, E)
        return jnp.concatenate([tp[:, :-1], tp[:, 1:]], axis=2)

    qb = jnp.pad(fold(q), ((0, 0), (0, Lp - L), (0, 0), (0, 0))).reshape(N, nb, A_BAND, H, E)
    kb = band(fold(k))
    vb = band(fold(v))
    s = jnp.einsum('nbqhe,nbkhe->nbhqk', qb, kb, preferred_element_type=jnp.float32)
    qi = jnp.arange(A_BAND)[:, None]
    kc = jnp.arange(2 * A_BAND)[None, :]
    dist = qi - kc + A_BAND
    kpos = jnp.arange(nb)[:, None, None] * A_BAND + kc[None] - A_BAND
    mask = (dist >= 0) & (dist <= A_BAND) & (kpos >= 0)
    s = jnp.where(mask[None, :, None], s, NEG)
    lse = jax.nn.logsumexp(s, axis=-1)
    p = jnp.exp(s - lse[..., None])
    o = jnp.einsum('nbhqk,nbkhe->nbqhe', p, vb.astype(jnp.float32))
    o = o.reshape(N, Lp, H, E)[:, :L]
    lse = lse.transpose(0, 1, 3, 2).reshape(N, Lp, H)[:, :L]

    def unfold(t):
        perm = (0, 2, 1) + tuple(range(3, t.ndim + 1))
        return t.reshape((B, dil, L) + t.shape[2:]).transpose(perm).reshape((B, S) + t.shape[2:])

    return unfold(o), unfold(lse)


def _dilated_step(q, k, v, buf, window, dil):
    T = q.shape[1]
    wb = buf.shape[1]
    kv = jnp.concatenate([buf, jnp.stack([k, v], axis=2).astype(buf.dtype)], axis=1)
    nk = window // dil + 1
    cidx = wb + jnp.arange(T)[:, None] - dil * jnp.arange(nk)[None, :]
    valid = cidx >= 0
    g = kv[:, jnp.maximum(cidx, 0)]
    s = jnp.einsum('bthe,btjhe->bthj', q, g[:, :, :, 0], preferred_element_type=jnp.float32)
    s = jnp.where(valid[None, :, None, :], s, NEG)
    lse = jax.nn.logsumexp(s, axis=-1)
    p = jnp.exp(s - lse[..., None])
    o = jnp.einsum('bthj,btjhe->bthe', p, g[:, :, :, 1].astype(jnp.float32))
    return o, lse, kv[:, T:]


def _combine_groups(outs, lses):
    w = jax.nn.softmax(jnp.stack(lses, axis=0), axis=0)
    return jnp.sum(w[..., None] * jnp.stack(outs, axis=0), axis=0)


def _retention(q, k, v, s0, chunk):
    B, T, H, Dk = q.shape
    Dv = v.shape[-1]
    n = T // chunk
    log_g = jnp.log(1.0 - 2.0 ** (-5.0 - jnp.arange(H, dtype=jnp.float32)))
    i = jnp.arange(chunk, dtype=jnp.float32)
    diff = i[:, None] - i[None, :]
    causal = diff >= 0
    dmat = jnp.where(causal[None], jnp.exp(jnp.where(causal, diff, 0.0)[None] * log_g[:, None, None]), 0.0)
    q_dec = jnp.exp((i[:, None] + 1.0) * log_g[None, :])
    k_dec = jnp.exp((chunk - 1.0 - i)[:, None] * log_g[None, :])
    s_dec = jnp.exp(chunk * log_g)

    def blocks(t):
        return t.astype(jnp.float32).reshape(B, n, chunk, H, t.shape[-1]).transpose(1, 0, 2, 3, 4)

    def step(state, qkv):
        qc, kc, vc = qkv
        a = jnp.einsum('bihd,bjhd->bhij', qc, kc) * dmat[None]
        o = (jnp.einsum('bhij,bjhe->bihe', a, vc)
             + jnp.einsum('bihd,bhde->bihe', qc, state) * q_dec[None, :, :, None])
        state = state * s_dec[None, :, None, None] + jnp.einsum('bjhd,bjhe->bhde', kc * k_dec[None, :, :, None], vc)
        return state, o

    s_fin, o = lax.scan(step, s0.astype(jnp.float32), (blocks(q), blocks(k), blocks(v)))
    return o.transpose(1, 0, 2, 3, 4).reshape(B, T, H, Dv), s_fin


def _block(x, pos, attend_a, s0, p):
    (ffn1_norm, ffn1_in, ffn1_out, mix_norm, w_in, a_q_norm, a_k_norm,
     w_pa, w_pb, w_o, ffn2_norm, ffn2_in, ffn2_out) = p
    B, T, _ = x.shape
    x = _half_ffn(x, ffn1_norm, ffn1_in, ffn1_out)
    h = _rmsnorm(x, mix_norm)
    qa, ka, va, qr, kr, vr, gr, ga, gb = jnp.split(h @ w_in, SPLIT_POINTS, axis=-1)
    ha = (B, T, N_A_GROUPS * A_HEADS, A_HEAD_DIM)
    g5 = (B, T, N_A_GROUPS, A_HEADS, A_HEAD_DIM)
    qa = (_partial_rope(_rmsnorm(qa.reshape(ha), a_q_norm), pos) * A_SCALE).reshape(g5)
    ka = _partial_rope(_rmsnorm(ka.reshape(ha), a_k_norm), pos).reshape(g5)
    va = va.reshape(g5)
    oa, kv_new = attend_a(qa, ka, va)
    qr = _retention_rotary(qr.reshape(B, T, R_HEADS, R_QK_DIM), pos)
    kr = _retention_rotary(kr.reshape(B, T, R_HEADS, R_QK_DIM), pos) * (R_QK_DIM ** -0.5)
    vr = vr.reshape(B, T, R_HEADS, R_V_DIM)
    chunk = R_CHUNK if T % R_CHUNK == 0 else T
    orr, s_new = _retention(qr, kr, vr, s0, chunk)
    ob = _rms_plain(orr).reshape(B, T, R_V_W) * jax.nn.silu(gr.astype(jnp.float32))
    m = (jax.nn.sigmoid(ga.astype(jnp.float32)) * (oa.reshape(B, T, A_HEADS * A_HEAD_DIM) @ w_pa)
         + jax.nn.sigmoid(gb.astype(jnp.float32)) * (ob @ w_pb))
    x = x + (m @ w_o).astype(x.dtype)
    x = _half_ffn(x, ffn2_norm, ffn2_in, ffn2_out)
    return x, kv_new, s_new


def _attend_prompt(qa, ka, va):
    T = qa.shape[1]
    outs, lses, kv = [], [], []
    for g, (win, dil) in enumerate(A_GROUPS):
        o, l = _dilated_prompt(qa[:, :, g], ka[:, :, g], va[:, :, g], dil)
        outs.append(o)
        lses.append(l)
        keep = min(win, T)
        kv.append(jnp.stack([ka[:, T - keep:, g], va[:, T - keep:, g]], axis=2))
    return _combine_groups(outs, lses), kv


def _attend_sample(bufs):
    def attend(qa, ka, va):
        outs, lses, kv = [], [], []
        for g, (win, dil) in enumerate(A_GROUPS):
            o, l, nb = _dilated_step(qa[:, :, g], ka[:, :, g], va[:, :, g], bufs[g], win, dil)
            outs.append(o)
            lses.append(l)
            kv.append(nb)
        return _combine_groups(outs, lses), kv
    return attend


def setup_inputs(seed: int = 0) -> dict:
    key = jax.random.key(seed)
    ks = jax.random.split(key, 19)
    f32 = jnp.float32

    def nrm(k, shape, scale):
        return jax.random.normal(k, shape, f32) * scale

    def gain(k, n):
        return 1.0 + 0.05 * jax.random.normal(k, (DEPTH, n), f32)

    kv_tail = (2, A_HEADS, A_HEAD_DIM)
    return {
        'x_prompt': nrm(ks[0], (BATCH, SEQ, D_MODEL), 1.0),
        'x_sample': nrm(ks[1], (DEC_BATCH, DEC_SEQ, D_MODEL), 1.0),
        'cache_kv_a0': nrm(ks[2], (DEPTH, DEC_BATCH, min(A_GROUPS[0][0], PAST_LEN)) + kv_tail, 1.0),
        'cache_kv_a1': nrm(ks[3], (DEPTH, DEC_BATCH, min(A_GROUPS[1][0], PAST_LEN)) + kv_tail, 1.0),
        'cache_kv_a2': nrm(ks[4], (DEPTH, DEC_BATCH, min(A_GROUPS[2][0], PAST_LEN)) + kv_tail, 1.0),
        'state_ret': nrm(ks[5], (DEPTH, DEC_BATCH, R_HEADS, R_QK_DIM, R_V_DIM), 0.5),
        'ffn1_norm': gain(ks[6], D_MODEL),
        'ffn1_in': nrm(ks[7], (DEPTH, D_MODEL, 2 * D_FF), D_MODEL ** -0.5),
        'ffn1_out': nrm(ks[8], (DEPTH, D_FF, D_MODEL), D_FF ** -0.5),
        'mix_norm': gain(ks[9], D_MODEL),
        'w_in': nrm(ks[10], (DEPTH, D_MODEL, D_IN), D_MODEL ** -0.5),
        'a_q_norm': gain(ks[11], A_HEAD_DIM),
        'a_k_norm': gain(ks[12], A_HEAD_DIM),
        'w_pa': nrm(ks[13], (DEPTH, A_HEADS * A_HEAD_DIM, D_MODEL), (A_HEADS * A_HEAD_DIM) ** -0.5),
        'w_pb': nrm(ks[14], (DEPTH, R_V_W, D_MODEL), R_V_W ** -0.5),
        'w_o': nrm(ks[15], (DEPTH, D_MODEL, D_MODEL), D_MODEL ** -0.5),
        'ffn2_norm': gain(ks[16], D_MODEL),
        'ffn2_in': nrm(ks[17], (DEPTH, D_MODEL, 2 * D_FF), D_MODEL ** -0.5),
        'ffn2_out': nrm(ks[18], (DEPTH, D_FF, D_MODEL), D_FF ** -0.5),
    }


def reference(x_prompt, x_sample, cache_kv_a0, cache_kv_a1, cache_kv_a2, state_ret,
              ffn1_norm, ffn1_in, ffn1_out, mix_norm, w_in, a_q_norm, a_k_norm,
              w_pa, w_pb, w_o, ffn2_norm, ffn2_in, ffn2_out):
    yp, ys = x_prompt, x_sample
    pos_p = jnp.arange(x_prompt.shape[1], dtype=jnp.int32)
    pos_s = PAST_LEN + jnp.arange(x_sample.shape[1], dtype=jnp.int32)
    kvp0, kvp1, kvp2, rp = [], [], [], []
    kvs0, kvs1, kvs2, rs = [], [], [], []
    for l in range(DEPTH):
        p = (ffn1_norm[l], ffn1_in[l], ffn1_out[l], mix_norm[l], w_in[l], a_q_norm[l], a_k_norm[l],
             w_pa[l], w_pb[l], w_o[l], ffn2_norm[l], ffn2_in[l], ffn2_out[l])
        s0 = jnp.zeros((yp.shape[0], R_HEADS, R_QK_DIM, R_V_DIM), jnp.float32)
        yp, kv_p, r_p = _block(yp, pos_p, _attend_prompt, s0, p)
        attend_s = _attend_sample((cache_kv_a0[l], cache_kv_a1[l], cache_kv_a2[l]))
        ys, kv_s, r_s = _block(ys, pos_s, attend_s, state_ret[l], p)
        kvp0.append(kv_p[0]); kvp1.append(kv_p[1]); kvp2.append(kv_p[2]); rp.append(r_p)
        kvs0.append(kv_s[0]); kvs1.append(kv_s[1]); kvs2.append(kv_s[2]); rs.append(r_s)
    return (yp, ys,
            jnp.stack(kvp0), jnp.stack(kvp1), jnp.stack(kvp2), jnp.stack(rp),
            jnp.stack(kvs0), jnp.stack(kvs1), jnp.stack(kvs2), jnp.stack(rs))
```

```cpp
#include <hip/hip_runtime.h>
#include <hip/hip_cooperative_groups.h>
#include <cstdio>
#include <cstdint>
namespace cg = cooperative_groups;

#define LAS __attribute__((address_space(3)))
typedef unsigned short bf16_t;
typedef short bf16x8 __attribute__((ext_vector_type(8)));
typedef short s16x4 __attribute__((ext_vector_type(4)));
typedef float f32x4 __attribute__((ext_vector_type(4)));
typedef unsigned u32x4 __attribute__((ext_vector_type(4)));
typedef unsigned u32x2 __attribute__((ext_vector_type(2)));

constexpr int DM = 1024, SEQ = 2048, NBATCH = 16, MPROMPT = NBATCH * SEQ, NSAMP = 32, MREAL = MPROMPT + NSAMP, MP = MPROMPT + 256;
constexpr int DFF = 2816, DIN = 12800;
constexpr int QA_OFF = 0, KA_OFF = 1536, VA_OFF = 3072, QR_OFF = 4608, KR_OFF = 5632, VR_OFF = 6656, GR_OFF = 8704, GA_OFF = 10752, GB_OFF = 11776;
constexpr float EPS = 1e-6f;
constexpr size_t OFF_Y = 0, OFF_YS = 33554432, OFF_KVP0 = 33587200, OFF_KVP1 = 35684352, OFF_KVP2 = 44072960, OFF_RP = 77627392,
                 OFF_KVS0 = 86016000, OFF_KVS1 = 90210304, OFF_KVS2 = 106987520, OFF_RS = 174096384;
constexpr int M32_COL = 512;
constexpr size_t MiB = 1u << 20;
constexpr size_t WS_SS0 = 0, WS_SS1 = 192 * 1024, WS_SS2 = 384 * 1024, WS_RSS = 576 * 1024, WS_CNT = 1536 * 1024, CTL_BYTES = 2 * MiB;
constexpr size_t WS_BAR = 1600 * 1024;
constexpr size_t WS_ROPE = 2 * MiB, WS_RROT = 2 * MiB + 256 * 1024;
constexpr size_t WS_W1T = 8 * MiB, WS_W2T = 19 * MiB, WS_WINT = 25 * MiB, WS_WPAT = 50 * MiB, WS_WPBT = 51 * MiB, WS_WOT = 55 * MiB, WS_W3T = 57 * MiB, WS_W4T = 68 * MiB;
constexpr size_t WS_XB = 74 * MiB, WS_XS = 139 * MiB, WS_KVNEW = 140 * MiB, WS_PROJ = 141 * MiB;
constexpr size_t WS_ACT = WS_PROJ, WS_X2B = WS_PROJ + 200 * MiB;
constexpr size_t WS_OG = WS_XB;
constexpr size_t WS_LSE = WS_W1T;
constexpr size_t WS_END = WS_PROJ + (size_t)MP * DIN * 2;
static_assert(WS_END <= 1024 * MiB, "ws map");
static_assert(WS_XB + (size_t)MP * DM * 2 <= WS_XS, "ws map xb");
constexpr int LDS_BYTES = 147456;

__device__ __forceinline__ unsigned cvt_pk_bf16(float lo, float hi) { unsigned r; asm volatile("v_cvt_pk_bf16_f32 %0, %1, %2" : "=v"(r) : "v"(lo), "v"(hi)); return r; }
__device__ __forceinline__ float bflo(unsigned w) { return __uint_as_float(w << 16); }
__device__ __forceinline__ float bfhi(unsigned w) { return __uint_as_float(w & 0xffff0000u); }
__device__ __forceinline__ float fast_sigmoid(float a) { return __builtin_amdgcn_rcpf(1.0f + __expf(-a)); }
__device__ __forceinline__ bf16x8 cat8(s16x4 a, s16x4 b) { return __builtin_shufflevector(a, b, 0, 1, 2, 3, 4, 5, 6, 7); }
__device__ __forceinline__ s16x4 trr(LAS unsigned char* p) { return __builtin_amdgcn_ds_read_tr16_b64_v4i16((LAS s16x4*)p); }
#define SCHED_BAR() __builtin_amdgcn_sched_barrier(0)
#define LDS_BARRIER() do { asm volatile("s_waitcnt lgkmcnt(0)" ::: "memory"); __builtin_amdgcn_s_barrier(); asm volatile("" ::: "memory"); } while (0)
__device__ __forceinline__ bf16x8 pack8(const f32x4& a, const f32x4& b) {
    u32x4 w; w.x = cvt_pk_bf16(a[0], a[1]); w.y = cvt_pk_bf16(a[2], a[3]); w.z = cvt_pk_bf16(b[0], b[1]); w.w = cvt_pk_bf16(b[2], b[3]);
    return __builtin_bit_cast(bf16x8, w);
}

struct Ptrs {
    const float* in[19];
    float* out;
    unsigned char* ws;
};
__device__ __forceinline__ const float* xin_row(const Ptrs& P, int row) { return row < MPROMPT ? P.in[0] + (size_t)row * DM : P.in[1] + (size_t)(row - MPROMPT) * DM; }
__device__ __forceinline__ float* x1_row(const Ptrs& P, int row) { return row < MPROMPT ? P.out + OFF_Y + (size_t)row * DM : (float*)(P.ws + WS_XS) + (size_t)(row - MPROMPT) * DM; }
__device__ __forceinline__ float* y_row(const Ptrs& P, int row) { return row < MPROMPT ? P.out + OFF_Y + (size_t)row * DM : P.out + OFF_YS + (size_t)(row - MPROMPT) * DM; }

namespace pg8 {
constexpr int BM = 256, BK = 64, HALF = 128, HTB = HALF * BK * 2, STAGE_BYTES = 8 * HTB, NXCD = 8, WGM = 8;
__host__ __device__ __forceinline__ int lds_byte(int r, int c) { const int st = (r >> 4) * 2 + (c >> 5), rr = r & 15, cc = c & 31, ob = rr * 64 + cc * 2; return st * 1024 + (ob ^ (((ob >> 9) & 1) << 5)); }
__host__ __device__ __forceinline__ void stage_rc(int b, int& R, int& C) { const int st = b / 1024, sb = b % 1024, swz = sb ^ (((sb >> 9) & 1) << 5); R = (st >> 1) * 16 + swz / 64; C = (st & 1) * 32 + (swz % 64) / 2; }
struct Unit { int pm, pn; };
struct Gemm { const bf16_t* A; const bf16_t* Bt; int lda, M, N, K; int a_tiled; };
struct StaticOrder {
    int nM, nN, nwg, G, c;
    __device__ void init(int M, int N, int G_, int c_) { nM = M / BM; nN = N / BM; nwg = nM * nN; G = G_; c = c_; }
    __device__ bool next(int i, Unit& u) const {
        const long L = (long)i * G + c; if (L >= nwg) return false;
        int wgid = (int)L; { const int q = nwg / NXCD, r = nwg % NXCD, xcd = wgid % NXCD, off = wgid / NXCD; wgid = (xcd < r ? xcd * (q + 1) : r * (q + 1) + (xcd - r) * q) + off; }
        const int nig = WGM * nN, gid = wgid / nig, fm = gid * WGM, gsz = (nM - fm) < WGM ? (nM - fm) : WGM;
        u.pm = fm + ((wgid % nig) % gsz); u.pn = (wgid % nig) / gsz; return true;
    }
};
template <class Epi>
__device__ __forceinline__ void gemm_phase(LAS unsigned char* lds, const Gemm g, const StaticOrder& S, const Epi& E) {
    int tid = threadIdx.x; asm volatile("" : "+v"(tid));
    const int wid = __builtin_amdgcn_readfirstlane(tid >> 6), lane = tid & 63, wr = wid >> 2, wc = wid & 3, fr = lane & 15, fq = lane >> 4;
    const int K = g.K, nt = K / BK;
    unsigned voffA[2], voffB[2];
#pragma unroll
    for (int i = 0; i < 2; ++i) { int R, C; stage_rc(tid * 16 + i * 8192, R, C); voffA[i] = (unsigned)(R * (g.a_tiled ? BK : g.lda) + C) * 2u; voffB[i] = (unsigned)(R * K + C) * 2u; }
    const size_t kstep = (size_t)(BK * 2);
    const size_t kstepA = g.a_tiled ? (size_t)(BM * BK * 2) : kstep;
    const size_t hstepA = g.a_tiled ? (size_t)(HALF * BK * 2) : (size_t)HALF * g.lda * 2, tstepA = g.a_tiled ? (size_t)nt * BM * BK * 2 : 2 * hstepA, hstepB = (size_t)HALF * K * 2, tstepB = 2 * hstepB;
    const unsigned ldsw = (unsigned)wid * 1024u;
    const int aoff = lds_byte(wr * 64 + fr, fq * 8), boff = lds_byte(wc * 32 + fr, fq * 8);
#define PG8_SA(b, h) (((b) * 2 + (h)) * HTB)
#define PG8_SB(b, h) ((4 + (b) * 2 + (h)) * HTB)
#define PG8_STAGE(bufoff, gbase, voff) do { _Pragma("unroll") for (int _i = 0; _i < 2; ++_i) \
        __builtin_amdgcn_global_load_lds((const unsigned*)((const char*)(gbase) + (voff)[_i]), (LAS unsigned*)(lds + (bufoff) + ldsw + _i * 8192), 16, 0, 0); } while (0)
#define PG8_LDA(dst, b, h) do { _Pragma("unroll") for (int m = 0; m < 4; ++m) _Pragma("unroll") for (int k = 0; k < 2; ++k) dst[m][k] = *(const LAS bf16x8*)(lds + PG8_SA(b, h) + aoff + m * 2048 + k * 1024); } while (0)
#define PG8_LDB(dst, b, h) do { _Pragma("unroll") for (int n = 0; n < 2; ++n) _Pragma("unroll") for (int k = 0; k < 2; ++k) dst[n][k] = *(const LAS bf16x8*)(lds + PG8_SB(b, h) + boff + n * 2048 + k * 1024); } while (0)
#define PG8_MMA(ai, bj, At, Bt) do { __builtin_amdgcn_s_setprio(1); _Pragma("unroll") for (int m = 0; m < 4; ++m) _Pragma("unroll") for (int n = 0; n < 2; ++n) _Pragma("unroll") for (int k = 0; k < 2; ++k) \
        acc[ai][bj][m][n] = __builtin_amdgcn_mfma_f32_16x16x32_bf16(Bt[n][k], At[m][k], acc[ai][bj][m][n], 0, 0, 0); __builtin_amdgcn_s_setprio(0); } while (0)
#define PG8_WAIT_V(n) asm volatile("s_waitcnt vmcnt(" #n ")" ::: "memory")
#define PG8_WAIT_L(n) asm volatile("s_waitcnt lgkmcnt(" #n ")" ::: "memory")
#define PG8_BAR __builtin_amdgcn_s_barrier()
#define PG8_SCHED __builtin_amdgcn_sched_barrier(0)
    Unit cur, nxt; int ui = 0;
    if (!S.next(0, cur)) return;
    f32x4 acc[2][2][4][2];
#pragma unroll
    for (int a = 0; a < 2; ++a)
#pragma unroll
        for (int b = 0; b < 2; ++b)
#pragma unroll
            for (int m = 0; m < 4; ++m)
#pragma unroll
                for (int n = 0; n < 2; ++n) acc[a][b][m][n] = (f32x4){0.f, 0.f, 0.f, 0.f};
    bf16x8 At[4][2], B0[2][2], B1[2][2];
    const char* cA = (const char*)g.A + (size_t)cur.pm * tstepA; const char* cB = (const char*)g.Bt + (size_t)cur.pn * tstepB;
    PG8_STAGE(PG8_SB(0, 0), cB, voffB); PG8_STAGE(PG8_SB(0, 1), cB + hstepB, voffB); PG8_STAGE(PG8_SA(0, 0), cA, voffA); PG8_STAGE(PG8_SA(0, 1), cA + hstepA, voffA);
    if (wr == 1) PG8_BAR;
    PG8_WAIT_V(2); PG8_BAR;
    PG8_STAGE(PG8_SB(1, 0), cB + kstep, voffB); PG8_STAGE(PG8_SA(1, 0), cA + kstepA, voffA); PG8_STAGE(PG8_SB(1, 1), cB + hstepB + kstep, voffB);
    PG8_WAIT_V(6); PG8_BAR;
    for (;;) {
        const bool has_next = S.next(ui + 1, nxt);
        const char* nA = has_next ? (const char*)g.A + (size_t)nxt.pm * tstepA : cA; const char* nB = has_next ? (const char*)g.Bt + (size_t)nxt.pn * tstepB : cB;
        for (int t = 0; t < nt; t += 2) {
            const bool last = (t == nt - 2);
            const char* a1 = cA + (size_t)(t + 1) * kstepA;
            const char* a2 = last ? nA : cA + (size_t)(t + 2) * kstepA; const char* b2 = last ? nB : cB + (size_t)(t + 2) * kstep;
            const char* a3 = a2 + kstepA; const char* b3 = b2 + kstep;
            PG8_LDB(B0, 0, 0); PG8_LDB(B1, 0, 1); PG8_SCHED; PG8_LDA(At, 0, 0); PG8_STAGE(PG8_SA(1, 1), a1 + hstepA, voffA);
            PG8_WAIT_V(8); PG8_WAIT_L(0); PG8_BAR; PG8_MMA(0, 0, At, B0); PG8_MMA(0, 1, At, B1); PG8_BAR; PG8_SCHED;
            PG8_LDA(At, 0, 1); PG8_STAGE(PG8_SB(0, 0), b2, voffB); PG8_STAGE(PG8_SB(0, 1), b2 + hstepB, voffB); PG8_STAGE(PG8_SA(0, 0), a2, voffA);
            PG8_WAIT_V(8); PG8_WAIT_L(0); PG8_BAR; PG8_MMA(1, 0, At, B0); PG8_MMA(1, 1, At, B1); PG8_BAR; PG8_SCHED;
            PG8_LDB(B0, 1, 0); PG8_LDB(B1, 1, 1); PG8_SCHED; PG8_LDA(At, 1, 0); PG8_STAGE(PG8_SA(0, 1), a2 + hstepA, voffA);
            PG8_WAIT_V(8); PG8_WAIT_L(0); PG8_BAR; PG8_MMA(0, 0, At, B0); PG8_MMA(0, 1, At, B1); PG8_BAR; PG8_SCHED;
            PG8_LDA(At, 1, 1); PG8_STAGE(PG8_SB(1, 0), b3, voffB); PG8_STAGE(PG8_SB(1, 1), b3 + hstepB, voffB); PG8_STAGE(PG8_SA(1, 0), a3, voffA);
            PG8_WAIT_V(8); PG8_WAIT_L(0); PG8_BAR; PG8_MMA(1, 0, At, B0); PG8_MMA(1, 1, At, B1); PG8_BAR; PG8_SCHED;
        }
        if (wr == 0) PG8_BAR;
        E(acc, cur, wr, wc, fr, fq);
        if (!has_next) break;
#pragma unroll
        for (int a = 0; a < 2; ++a)
#pragma unroll
            for (int b = 0; b < 2; ++b)
#pragma unroll
                for (int m = 0; m < 4; ++m)
#pragma unroll
                    for (int n = 0; n < 2; ++n) acc[a][b][m][n] = (f32x4){0.f, 0.f, 0.f, 0.f};
        cur = nxt; cA = nA; cB = nB; ++ui;
        if (wr == 1) PG8_BAR;
    }
    PG8_WAIT_V(0);
    PG8_BAR;
#undef PG8_SA
#undef PG8_SB
#undef PG8_STAGE
#undef PG8_LDA
#undef PG8_LDB
#undef PG8_MMA
#undef PG8_WAIT_V
#undef PG8_WAIT_L
#undef PG8_BAR
#undef PG8_SCHED
}
}
using pg8::Unit;
typedef f32x4 Acc[2][2][4][2];

struct EpiSwiglu {
    bf16_t* act; const float* ss;
    __device__ __forceinline__ void operator()(const Acc& acc, const Unit& u, int wr, int wc, int fr, int fq) const {
        float ssv[2][4];
#pragma unroll
        for (int ai = 0; ai < 2; ++ai)
#pragma unroll
            for (int m = 0; m < 4; ++m) ssv[ai][m] = ss[u.pm * 256 + ai * 128 + wr * 64 + m * 16 + fr];
        SCHED_BAR();
#pragma unroll
        for (int ai = 0; ai < 2; ++ai)
#pragma unroll
            for (int m = 0; m < 4; ++m) {
                const int row = u.pm * 256 + ai * 128 + wr * 64 + m * 16 + fr;
                const float rs = rsqrtf(ssv[ai][m] * (1.0f / DM) + EPS);
                bf16_t* dst = act + ((size_t)((row >> 8) * (DFF / 64) + u.pn * 2 + (wc >> 1)) * 256 + (row & 255)) * 64 + (wc & 1) * 32 + fq * 8;
                u32x4 w;
#pragma unroll
                for (int n = 0; n < 2; ++n) {
                    const f32x4 a = acc[ai][0][m][n] * rs, b = acc[ai][1][m][n] * rs; f32x4 v;
#pragma unroll
                    for (int j = 0; j < 4; ++j) v[j] = a[j] * fast_sigmoid(a[j]) * b[j];
                    if (n == 0) { w.x = cvt_pk_bf16(v[0], v[1]); w.y = cvt_pk_bf16(v[2], v[3]); } else { w.z = cvt_pk_bf16(v[0], v[1]); w.w = cvt_pk_bf16(v[2], v[3]); }
                }
                *(u32x4*)dst = w;
            }
    }
};
template <int MODE> struct EpiResid {
    Ptrs P; bf16_t* xb; float* ssn;
    __device__ __forceinline__ void operator()(const Acc& acc, const Unit& u, int wr, int wc, int fr, int fq) const {
        const float sc = (MODE == 1) ? 1.0f : 0.5f;
        const int colb = u.pn * 256 + wc * 64 + fq * 8;
#pragma unroll
        for (int ai = 0; ai < 2; ++ai) {
            f32x4 R[4][2][2];
#pragma unroll
            for (int m = 0; m < 4; ++m) {
                const int row = u.pm * 256 + ai * 128 + wr * 64 + m * 16 + fr; const int rr = row < MREAL ? row : 0;
                const float* res = ((MODE == 0) ? xin_row(P, rr) : (const float*)x1_row(P, rr)) + colb;
#pragma unroll
                for (int bj = 0; bj < 2; ++bj)
#pragma unroll
                    for (int n = 0; n < 2; ++n) R[m][bj][n] = *(const f32x4*)(res + bj * 32 + n * 4);
            }
            SCHED_BAR();
#pragma unroll
            for (int m = 0; m < 4; ++m) {
                const int row = u.pm * 256 + ai * 128 + wr * 64 + m * 16 + fr;
                const bool ok = row < MREAL; const int rr = ok ? row : 0;
                float* dst = ((MODE == 2) ? y_row(P, rr) : x1_row(P, rr)) + colb;
                float part = 0.f;
#pragma unroll
                for (int bj = 0; bj < 2; ++bj) {
                    const f32x4 o0 = R[m][bj][0] + acc[ai][bj][m][0] * sc, o1 = R[m][bj][1] + acc[ai][bj][m][1] * sc;
                    if (ok) {
                        *(f32x4*)(dst + bj * 32) = o0; *(f32x4*)(dst + bj * 32 + 4) = o1;
                        if (MODE != 2) { part += ((o0[0] * o0[0] + o0[1] * o0[1]) + (o0[2] * o0[2] + o0[3] * o0[3])) + ((o1[0] * o1[0] + o1[1] * o1[1]) + (o1[2] * o1[2] + o1[3] * o1[3]));
                            u32x4 w; w.x = cvt_pk_bf16(o0[0], o0[1]); w.y = cvt_pk_bf16(o0[2], o0[3]); w.z = cvt_pk_bf16(o1[0], o1[1]); w.w = cvt_pk_bf16(o1[2], o1[3]);
                            *(u32x4*)(xb + (size_t)row * DM + colb + bj * 32) = w; }
                    }
                }
                if (MODE != 2) { part += __shfl_xor(part, 16); part += __shfl_xor(part, 32); if (ok && fq == 0) atomicAdd(ssn + row, part); }
            }
        }
    }
};
struct EpiProj {
    Ptrs P; bf16_t* proj; const float* ss1; const float* rope; const float* rrot; float* kvnew;
    __device__ __forceinline__ void operator()(const Acc& acc, const Unit& u, int wr, int wc, int fr, int fq) const {
        const int pn = u.pn;
        const int kind = pn < 6 ? 0 : pn < 12 ? 1 : pn < 18 ? 2 : pn < 22 ? 3 : pn < 26 ? 4 : pn < 34 ? 5 : pn < 42 ? 6 : 7;
        const float* gp = P.in[kind == 0 ? 11 : 12];
#pragma unroll
        for (int ai = 0; ai < 2; ++ai)
#pragma unroll
            for (int m = 0; m < 4; ++m) {
                const int row = u.pm * 256 + ai * 128 + wr * 64 + m * 16 + fr;
                const float rs = rsqrtf(ss1[row] * (1.0f / DM) + EPS);
                const int posidx = row < MPROMPT ? (row & 2047) : 2048;
                f32x4 v[2][2];
#pragma unroll
                for (int bj = 0; bj < 2; ++bj)
#pragma unroll
                    for (int n = 0; n < 2; ++n) v[bj][n] = acc[ai][bj][m][n] * rs;
                if (kind <= 1) {
                    float s2 = 0.f;
#pragma unroll
                    for (int bj = 0; bj < 2; ++bj)
#pragma unroll
                        for (int n = 0; n < 2; ++n) s2 += (v[bj][n][0] * v[bj][n][0] + v[bj][n][1] * v[bj][n][1]) + (v[bj][n][2] * v[bj][n][2] + v[bj][n][3] * v[bj][n][3]);
                    s2 += __shfl_xor(s2, 16); s2 += __shfl_xor(s2, 32);
                    const float r = rsqrtf(s2 * (1.0f / 64.0f) + EPS);
#pragma unroll
                    for (int bj = 0; bj < 2; ++bj)
#pragma unroll
                        for (int n = 0; n < 2; ++n) { const f32x4 gv = *(const f32x4*)(gp + bj * 32 + fq * 8 + n * 4); v[bj][n] = v[bj][n] * r * gv; }
#pragma unroll
                    for (int n = 0; n < 2; ++n) { const f32x4 csa = *(const f32x4*)(rope + ((size_t)posidx * 8 + 4 * n) * 2), csb = *(const f32x4*)(rope + ((size_t)posidx * 8 + 4 * n) * 2 + 4);
                        const float cc[4] = {csa[0], csa[2], csb[0], csb[2]}, sn[4] = {csa[1], csa[3], csb[1], csb[3]};
#pragma unroll
                        for (int j = 0; j < 4; ++j) { const float mine = v[0][n][j], other = __shfl_xor(mine, 16);
                            const float rot = (fq == 0) ? (mine * cc[j] - other * sn[j]) : (mine * cc[j] + other * sn[j]);
                            v[0][n][j] = (fq < 2) ? rot : mine; } }
                    if (kind == 0) {
#pragma unroll
                        for (int bj = 0; bj < 2; ++bj)
#pragma unroll
                            for (int n = 0; n < 2; ++n) v[bj][n] = v[bj][n] * 0.125f;
                    }
                } else if (kind == 3 || kind == 4) {
                    const float ksc = (kind == 4) ? 0.0625f : 1.0f;
#pragma unroll
                    for (int bj = 0; bj < 2; ++bj)
#pragma unroll
                        for (int n = 0; n < 2; ++n) {
                            const int i0 = (wc * 64 + bj * 32 + fq * 8 + n * 4) >> 1;
                            const f32x4 cs = *(const f32x4*)(rrot + ((size_t)posidx * 128 + i0) * 2);
                            const f32x4 x = v[bj][n]; f32x4 o;
                            o[0] = (x[0] * cs[0] - x[1] * cs[1]) * ksc; o[1] = (x[1] * cs[0] + x[0] * cs[1]) * ksc;
                            o[2] = (x[2] * cs[2] - x[3] * cs[3]) * ksc; o[3] = (x[3] * cs[2] + x[2] * cs[3]) * ksc;
                            v[bj][n] = o;
                        }
                } else if (kind == 6) {
#pragma unroll
                    for (int bj = 0; bj < 2; ++bj)
#pragma unroll
                        for (int n = 0; n < 2; ++n)
#pragma unroll
                            for (int j = 0; j < 4; ++j) { const float a = v[bj][n][j]; v[bj][n][j] = a * fast_sigmoid(a); }
                } else if (kind == 7) {
#pragma unroll
                    for (int bj = 0; bj < 2; ++bj)
#pragma unroll
                        for (int n = 0; n < 2; ++n)
#pragma unroll
                            for (int j = 0; j < 4; ++j) v[bj][n][j] = fast_sigmoid(v[bj][n][j]);
                }
                bf16_t* dst = proj + (size_t)row * DIN + pn * 256 + wc * 64 + fq * 8;
#pragma unroll
                for (int bj = 0; bj < 2; ++bj) { u32x4 w; w.x = cvt_pk_bf16(v[bj][0][0], v[bj][0][1]); w.y = cvt_pk_bf16(v[bj][0][2], v[bj][0][3]);
                    w.z = cvt_pk_bf16(v[bj][1][0], v[bj][1][1]); w.w = cvt_pk_bf16(v[bj][1][2], v[bj][1][3]); *(u32x4*)(dst + bj * 32) = w; }
                if (kind == 1 || kind == 2) {
                    const int s = kind - 1, pq = pn - (kind == 1 ? 6 : 12), gi = pq >> 1, hh = (pq & 1) * 4 + wc;
                    float* o32 = nullptr;
                    if (row < MPROMPT) {
                        const int b = row >> 11, t = row & 2047, keep = 128 << (2 * gi), tt = t - (SEQ - keep);
                        if (tt >= 0) { const size_t base = gi == 0 ? OFF_KVP0 : gi == 1 ? OFF_KVP1 : OFF_KVP2;
                            o32 = P.out + base + ((((size_t)b * keep + tt) * 2 + s) * 8 + hh) * 64 + fq * 8; }
                    } else if (row < MREAL) {
                        o32 = kvnew + (size_t)(row - MPROMPT) * 3072 + s * 1536 + gi * 512 + hh * 64 + fq * 8;
                    }
                    if (o32) {
#pragma unroll
                        for (int bj = 0; bj < 2; ++bj)
#pragma unroll
                            for (int n = 0; n < 2; ++n) *(f32x4*)(o32 + bj * 32 + n * 4) = v[bj][n];
                    }
                }
            }
    }
};
struct EpiGate1 {
    bf16_t* proj;
    __device__ __forceinline__ void operator()(const Acc& acc, const Unit& u, int wr, int wc, int fr, int fq) const {
        const int colb = u.pn * 256 + wc * 64 + fq * 8;
        u32x4 Gt[2][4][2];
#pragma unroll
        for (int ai = 0; ai < 2; ++ai)
#pragma unroll
            for (int m = 0; m < 4; ++m) { const int row = u.pm * 256 + ai * 128 + wr * 64 + m * 16 + fr; const bf16_t* gp = proj + (size_t)row * DIN + GA_OFF + colb;
#pragma unroll
                for (int bj = 0; bj < 2; ++bj) Gt[ai][m][bj] = *(const u32x4*)(gp + bj * 32); }
        SCHED_BAR();
#pragma unroll
        for (int ai = 0; ai < 2; ++ai)
#pragma unroll
            for (int m = 0; m < 4; ++m) { const int row = u.pm * 256 + ai * 128 + wr * 64 + m * 16 + fr; float* mp = (float*)(proj + (size_t)row * DIN + M32_COL) + colb;
#pragma unroll
                for (int bj = 0; bj < 2; ++bj) { const u32x4 gw = Gt[ai][m][bj];
                    const f32x4 g0 = {bflo(gw.x), bfhi(gw.x), bflo(gw.y), bfhi(gw.y)}, g1 = {bflo(gw.z), bfhi(gw.z), bflo(gw.w), bfhi(gw.w)};
                    *(f32x4*)(mp + bj * 32) = acc[ai][bj][m][0] * g0; *(f32x4*)(mp + bj * 32 + 4) = acc[ai][bj][m][1] * g1; } }
    }
};
struct EpiGate2 {
    const bf16_t* proj; bf16_t* mb;
    __device__ __forceinline__ void operator()(const Acc& acc, const Unit& u, int wr, int wc, int fr, int fq) const {
        const int colb = u.pn * 256 + wc * 64 + fq * 8;
#pragma unroll
        for (int ai = 0; ai < 2; ++ai)
#pragma unroll
            for (int mh = 0; mh < 2; ++mh) {
                u32x4 Gt[2][2]; f32x4 Mv[2][2][2];
#pragma unroll
                for (int m2 = 0; m2 < 2; ++m2) { const int row = u.pm * 256 + ai * 128 + wr * 64 + (2 * mh + m2) * 16 + fr;
                    const bf16_t* gp = proj + (size_t)row * DIN + GB_OFF + colb; const float* mp = (const float*)(proj + (size_t)row * DIN + M32_COL) + colb;
#pragma unroll
                    for (int bj = 0; bj < 2; ++bj) { Gt[m2][bj] = *(const u32x4*)(gp + bj * 32); Mv[m2][bj][0] = *(const f32x4*)(mp + bj * 32); Mv[m2][bj][1] = *(const f32x4*)(mp + bj * 32 + 4); } }
                SCHED_BAR();
#pragma unroll
                for (int m2 = 0; m2 < 2; ++m2) { const int m = 2 * mh + m2; const int row = u.pm * 256 + ai * 128 + wr * 64 + m * 16 + fr;
#pragma unroll
                    for (int bj = 0; bj < 2; ++bj) { const u32x4 gw = Gt[m2][bj];
                        const f32x4 g0 = {bflo(gw.x), bfhi(gw.x), bflo(gw.y), bfhi(gw.y)}, g1 = {bflo(gw.z), bfhi(gw.z), bflo(gw.w), bfhi(gw.w)};
                        const f32x4 o0 = Mv[m2][bj][0] + acc[ai][bj][m][0] * g0, o1 = Mv[m2][bj][1] + acc[ai][bj][m][1] * g1;
                        u32x4 w; w.x = cvt_pk_bf16(o0[0], o0[1]); w.y = cvt_pk_bf16(o0[2], o0[3]); w.z = cvt_pk_bf16(o1[0], o1[1]); w.w = cvt_pk_bf16(o1[2], o1[3]);
                        *(u32x4*)(mb + (size_t)row * DM + colb + bj * 32) = w; } }
                SCHED_BAR();
            }
    }
};

template <class Epi>
__device__ __forceinline__ void skinny_phase(LAS unsigned char* lds, const pg8::Gemm g, const Epi& E, int G, int bx) {
    int tid = threadIdx.x; asm volatile("" : "+v"(tid));
    const int wid = __builtin_amdgcn_readfirstlane(tid >> 6), lane = tid & 63, fr = lane & 15, fq = lane >> 4;
    const int nT = (g.N / 256) * 4, K = g.K, KS = K / 8;
    for (int task = G - 1 - bx; task < nT; task += G) {
        const int pn = task >> 2, wc = task & 3;
        f32x4 a8[2][2][2];
#pragma unroll
        for (int b = 0; b < 2; ++b)
#pragma unroll
            for (int m = 0; m < 2; ++m)
#pragma unroll
                for (int n = 0; n < 2; ++n) a8[b][m][n] = (f32x4){0.f, 0.f, 0.f, 0.f};
        const bf16_t* bp = g.Bt + (size_t)(256 * pn + 32 * wc + fr) * K + 8 * fq;
        const bf16_t* apl = g.a_tiled ? g.A + ((size_t)128 * (K / 64)) * (256 * 64) + (size_t)fr * 64 + 8 * fq : g.A + (size_t)(MPROMPT + fr) * g.lda + 8 * fq;
        const size_t am = g.a_tiled ? (size_t)16 * 64 : (size_t)16 * g.lda;
        const int kend = (wid + 1) * KS;
#pragma unroll 1
        for (int k0 = wid * KS; k0 < kend; k0 += 128) {
            bf16x8 Af[4][2], Bf[4][2][2];
#pragma unroll
            for (int kk = 0; kk < 4; ++kk) { const int k = k0 + 32 * kk;
                if (k < kend) {
                    const bf16_t* ak = g.a_tiled ? apl + (size_t)(k >> 6) * (256 * 64) + (k & 63) : apl + k;
#pragma unroll
                    for (int m = 0; m < 2; ++m) Af[kk][m] = *(const bf16x8*)(ak + m * am);
#pragma unroll
                    for (int bj = 0; bj < 2; ++bj)
#pragma unroll
                        for (int n = 0; n < 2; ++n) Bf[kk][bj][n] = *(const bf16x8*)(bp + (size_t)(128 * bj + 16 * n) * K + k);
                } else {
#pragma unroll
                    for (int m = 0; m < 2; ++m) Af[kk][m] = (bf16x8){0, 0, 0, 0, 0, 0, 0, 0};
#pragma unroll
                    for (int bj = 0; bj < 2; ++bj)
#pragma unroll
                        for (int n = 0; n < 2; ++n) Bf[kk][bj][n] = (bf16x8){0, 0, 0, 0, 0, 0, 0, 0};
                } }
            SCHED_BAR();
#pragma unroll
            for (int kk = 0; kk < 4; ++kk)
#pragma unroll
                for (int bj = 0; bj < 2; ++bj)
#pragma unroll
                    for (int n = 0; n < 2; ++n)
#pragma unroll
                        for (int m = 0; m < 2; ++m) a8[bj][m][n] = __builtin_amdgcn_mfma_f32_16x16x32_bf16(Bf[kk][bj][n], Af[kk][m], a8[bj][m][n], 0, 0, 0);
            SCHED_BAR();
        }
        LAS f32x4* red = (LAS f32x4*)lds;
        __syncthreads();
#pragma unroll
        for (int b = 0; b < 2; ++b)
#pragma unroll
            for (int m = 0; m < 2; ++m)
#pragma unroll
                for (int n = 0; n < 2; ++n) red[(((b * 2 + m) * 2 + n) * 8 + wid) * 64 + lane] = a8[b][m][n];
        __syncthreads();
        if (wid == 0) {
            Acc acc;
#pragma unroll
            for (int a = 0; a < 2; ++a)
#pragma unroll
                for (int b = 0; b < 2; ++b)
#pragma unroll
                    for (int m = 0; m < 4; ++m)
#pragma unroll
                        for (int n = 0; n < 2; ++n) acc[a][b][m][n] = (f32x4){0.f, 0.f, 0.f, 0.f};
#pragma unroll
            for (int b = 0; b < 2; ++b)
#pragma unroll
                for (int m = 0; m < 2; ++m)
#pragma unroll
                    for (int n = 0; n < 2; ++n) { f32x4 t = {0.f, 0.f, 0.f, 0.f};
#pragma unroll
                        for (int w8 = 0; w8 < 8; ++w8) t += red[(((b * 2 + m) * 2 + n) * 8 + w8) * 64 + lane];
                        acc[0][b][m][n] = t; SCHED_BAR(); }
#pragma unroll
            for (int a = 0; a < 2; ++a)
#pragma unroll
                for (int b = 0; b < 2; ++b)
#pragma unroll
                    for (int m = 0; m < 4; ++m)
#pragma unroll
                        for (int n = 0; n < 2; ++n) asm volatile("" : "+v"(acc[a][b][m][n]));
            const Unit u{128, pn};
            E(acc, u, 0, wc, fr, fq);
        }
        __syncthreads();
    }
}

__device__ __forceinline__ void p0_transpose_item(const float* W, int K, int Nsrc, bf16_t* WT, int mode, const float* gain, LAS float* scr, int item, int nblk, int lane) {
    const int kb = item / nblk, nb2 = item % nblk, k0 = 64 * kb;
    const int g32 = 2 * nb2 + (lane >> 5);
    const int tile = g32 >> 3, within = g32 & 7, bj = within >> 2, wc = within & 3;
    const int nsrc = (((mode & 1) == 0) ? (tile * 256 + 64 * wc + 32 * bj) : ((bj ? DFF : 0) + tile * 128 + 32 * wc)) + (lane & 31);
    float v[64];
#pragma unroll
    for (int i = 0; i < 64; ++i) v[i] = W[(size_t)(k0 + i) * Nsrc + nsrc];
#pragma unroll
    for (int i = 0; i < 64; ++i) scr[i * 65 + lane] = v[i] * (gain ? gain[k0 + i] : 1.0f);
    asm volatile("s_waitcnt lgkmcnt(0)" ::: "memory");
    const int c = lane & 7;
#pragma unroll
    for (int j = 0; j < 8; ++j) { const int n = (lane >> 3) + 8 * j, wi = n & 31; const int ns = (n & 32) + ((mode & 2) ? (8 * ((wi >> 2) & 3) + 4 * (wi >> 4) + (wi & 3)) : wi);
        const LAS float* sp = scr + (8 * c) * 65 + ns;
        u32x4 o; o.x = cvt_pk_bf16(sp[0 * 65], sp[1 * 65]); o.y = cvt_pk_bf16(sp[2 * 65], sp[3 * 65]); o.z = cvt_pk_bf16(sp[4 * 65], sp[5 * 65]); o.w = cvt_pk_bf16(sp[6 * 65], sp[7 * 65]);
        *(u32x4*)(WT + (size_t)(nb2 * 64 + n) * K + k0 + 8 * c) = o; }
    asm volatile("s_waitcnt lgkmcnt(0)" ::: "memory");
}
__device__ __forceinline__ double my_exp(double x) {
    const double LN2 = 0.6931471805599453094, ILN2 = 1.4426950408889634074; const double n = __builtin_rint(x * ILN2); const double r = x - n * LN2;
    double t = 1.0;
#pragma unroll
    for (int k = 16; k >= 1; --k) t = 1.0 + t * r * (1.0 / (double)k);
    const long long e = (long long)n + 1023; return t * __builtin_bit_cast(double, (unsigned long long)e << 52);
}
__device__ __forceinline__ void my_sincos(double a, double& s, double& c) {
    const double ITWO_PI = 0.15915494309189533577; const double n = __builtin_rint(a * ITWO_PI); const double r = __builtin_fma(-n, 2.4492935982947064e-16, a - n * 6.283185307179586);
    const double r2 = r * r; double ts = 1.0, tc = 1.0;
#pragma unroll
    for (int k = 14; k >= 1; --k) { ts = 1.0 - ts * r2 * (1.0 / (double)((2 * k) * (2 * k + 1))); tc = 1.0 - tc * r2 * (1.0 / (double)((2 * k - 1) * (2 * k))); }
    s = r * ts; c = tc;
}

__device__ __forceinline__ float ret_l2g(int h) { return h == 0 ? -0.04580368961312479f : h == 1 ? -0.02272007650008353f : h == 2 ? -0.011315313227834146f : -0.005646563141142063f; }
constexpr int RK_P = 560, RS_P = 528, RV_P = 144, R_KI = 0, R_ST = 71680, R_VI = 105472;
__device__ __forceinline__ void ret_unit(LAS unsigned char* lds, bf16_t* proj, float* out, float* rss, unsigned* cnt, int unit, bool same_xcd) {
    const int tid = threadIdx.x, lane = tid & 63, w = __builtin_amdgcn_readfirstlane(tid >> 6), l16 = lane & 15, fq = lane >> 4, tq = l16 >> 2, tp = l16 & 3;
    const int bh = unit >> 3, es = unit & 7, b = bh >> 2, h = bh & 3;
    const float l2g = ret_l2g(h), g128 = exp2f(l2g * 128.0f);
    LAS unsigned char* KI = lds + R_KI; LAS unsigned char* ST = lds + R_ST; LAS unsigned char* VI = lds + R_VI;
    __syncthreads();
    for (int i = tid; i < 33792 / 4; i += 512) ((LAS unsigned*)ST)[i] = 0u;
    f32x4 Sacc[2][4];
#pragma unroll
    for (int dt = 0; dt < 2; ++dt)
#pragma unroll
        for (int et = 0; et < 4; ++et) Sacc[dt][et] = (f32x4){0.f, 0.f, 0.f, 0.f};
    const size_t rowbase = (size_t)b * SEQ;
    const int qi = 16 * w + l16;
    u32x4 Kn[8], Vn[2]; bf16x8 Qn[8]; u32x2 Gn[4];
    const unsigned offK = (unsigned)((tid >> 5) * DIN + 8 * (tid & 31)) * 2u, offV = (unsigned)((tid >> 3) * DIN + 8 * (tid & 7)) * 2u;
    const unsigned offQ = (unsigned)(qi * DIN + 8 * fq) * 2u, offG = (unsigned)(qi * DIN + 4 * fq) * 2u;
    const char* pb = (const char*)proj;
#define RET_LOAD_KV(c_) do { const size_t ub_ = (rowbase + 128 * (size_t)(c_)) * DIN * 2; \
        _Pragma("unroll") for (int it_ = 0; it_ < 8; ++it_) Kn[it_] = *(const u32x4*)(pb + (ub_ + ((size_t)(16 * it_) * DIN + KR_OFF + 256 * h) * 2) + offK); \
        _Pragma("unroll") for (int it_ = 0; it_ < 2; ++it_) Vn[it_] = *(const u32x4*)(pb + (ub_ + ((size_t)(64 * it_) * DIN + VR_OFF + 512 * h + 64 * es) * 2) + offV); } while (0)
#define RET_LOAD_QG(c_) do { const size_t ub_ = (rowbase + 128 * (size_t)(c_)) * DIN * 2; \
        _Pragma("unroll") for (int ks_ = 0; ks_ < 8; ++ks_) Qn[ks_] = *(const bf16x8*)(pb + (ub_ + (size_t)(QR_OFF + 256 * h + 32 * ks_) * 2) + offQ); \
        _Pragma("unroll") for (int et_ = 0; et_ < 4; ++et_) Gn[et_] = *(const u32x2*)(pb + (ub_ + (size_t)(GR_OFF + 512 * h + 64 * es + 16 * et_) * 2) + offG); } while (0)
    RET_LOAD_KV(0); RET_LOAD_QG(0);
#pragma unroll 1
    for (int c = 0; c < 16; ++c) {
        const size_t R0 = rowbase + 128 * c;
#pragma unroll
        for (int it = 0; it < 8; ++it) { const int p = tid + 512 * it; *(LAS u32x4*)(KI + (p >> 5) * RK_P + (p & 31) * 16) = Kn[it]; }
#pragma unroll
        for (int it = 0; it < 2; ++it) { const int p = tid + 512 * it, j = p >> 3, pc = p & 7; const u32x4 v = Vn[it];
            const float sc = exp2f(l2g * (float)(127 - j));
            u32x4 o; o.x = cvt_pk_bf16(bflo(v.x) * sc, bfhi(v.x) * sc); o.y = cvt_pk_bf16(bflo(v.y) * sc, bfhi(v.y) * sc);
            o.z = cvt_pk_bf16(bflo(v.z) * sc, bfhi(v.z) * sc); o.w = cvt_pk_bf16(bflo(v.w) * sc, bfhi(v.w) * sc);
            *(LAS u32x4*)(VI + j * RV_P + pc * 16) = o; }
        bf16x8 Qf[8]; u32x2 Gc[4];
#pragma unroll
        for (int ks = 0; ks < 8; ++ks) Qf[ks] = Qn[ks];
#pragma unroll
        for (int et = 0; et < 4; ++et) Gc[et] = Gn[et];
        SCHED_BAR();
        if (c < 15) RET_LOAD_KV(c + 1);
        SCHED_BAR();
        LDS_BARRIER();
        f32x4 O[4];
#pragma unroll
        for (int et = 0; et < 4; ++et) O[et] = (f32x4){0.f, 0.f, 0.f, 0.f};
#pragma unroll
        for (int ks = 0; ks < 8; ++ks) { bf16x8 F[4];
#pragma unroll
            for (int et = 0; et < 4; ++et) F[et] = *(const LAS bf16x8*)(ST + (16 * et + l16) * RS_P + (32 * ks + 8 * fq) * 2);
            SCHED_BAR();
#pragma unroll
            for (int et = 0; et < 4; ++et) O[et] = __builtin_amdgcn_mfma_f32_16x16x32_bf16(F[et], Qf[ks], O[et], 0, 0, 0);
            SCHED_BAR(); }
#pragma unroll
        for (int et = 0; et < 4; ++et) O[et] = O[et] * g128;
#pragma unroll
        for (int s = 0; s < 4; ++s) {
            if (2 * s <= w) {
                f32x4 T0 = {0.f, 0.f, 0.f, 0.f}, T1 = {0.f, 0.f, 0.f, 0.f};
                const bool two = (2 * s + 1 <= w);
#pragma unroll
                for (int hb = 0; hb < 2; ++hb) { bf16x8 F[8];
#pragma unroll
                    for (int k4 = 0; k4 < 4; ++k4) { F[k4] = *(const LAS bf16x8*)(KI + (32 * s + l16) * RK_P + (32 * (4 * hb + k4) + 8 * fq) * 2);
                        F[4 + k4] = *(const LAS bf16x8*)(KI + (32 * s + 16 + l16) * RK_P + (32 * (4 * hb + k4) + 8 * fq) * 2); }
                    SCHED_BAR();
#pragma unroll
                    for (int k4 = 0; k4 < 4; ++k4) { T0 = __builtin_amdgcn_mfma_f32_16x16x32_bf16(F[k4], Qf[4 * hb + k4], T0, 0, 0, 0);
                        if (two) T1 = __builtin_amdgcn_mfma_f32_16x16x32_bf16(F[4 + k4], Qf[4 * hb + k4], T1, 0, 0, 0); }
                    SCHED_BAR(); }
                s16x4 tv[8];
#pragma unroll
                for (int et = 0; et < 4; ++et) { tv[2 * et] = trr(VI + (32 * s + 4 * fq + tq) * RV_P + (16 * et + 4 * tp) * 2);
                    tv[2 * et + 1] = trr(VI + (32 * s + 16 + 4 * fq + tq) * RV_P + (16 * et + 4 * tp) * 2); }
#pragma unroll
                for (int jj = 0; jj < 4; ++jj) { if (32 * s + 4 * fq + jj > qi) T0[jj] = 0.f; if (!two || 32 * s + 16 + 4 * fq + jj > qi) T1[jj] = 0.f; }
                const bf16x8 Pf = pack8(T0, T1);
                SCHED_BAR();
#pragma unroll
                for (int et = 0; et < 4; ++et) O[et] = __builtin_amdgcn_mfma_f32_16x16x32_bf16(cat8(tv[2 * et], tv[2 * et + 1]), Pf, O[et], 0, 0, 0);
                SCHED_BAR();
            }
        }
        SCHED_BAR();
        if (c < 15) RET_LOAD_QG(c + 1);
        SCHED_BAR();
#pragma unroll
        for (int dt = 0; dt < 2; ++dt)
#pragma unroll
            for (int et = 0; et < 4; ++et) Sacc[dt][et] = Sacc[dt][et] * g128;
#pragma unroll
        for (int s = 0; s < 4; ++s) {
            s16x4 ta[4], tb[8];
#pragma unroll
            for (int dt = 0; dt < 2; ++dt) { ta[2 * dt] = trr(KI + (32 * s + 8 * fq + tq) * RK_P + (32 * w + 16 * dt + 4 * tp) * 2);
                ta[2 * dt + 1] = trr(KI + (32 * s + 8 * fq + 4 + tq) * RK_P + (32 * w + 16 * dt + 4 * tp) * 2); }
#pragma unroll
            for (int et = 0; et < 4; ++et) { tb[2 * et] = trr(VI + (32 * s + 8 * fq + tq) * RV_P + (16 * et + 4 * tp) * 2);
                tb[2 * et + 1] = trr(VI + (32 * s + 8 * fq + 4 + tq) * RV_P + (16 * et + 4 * tp) * 2); }
            SCHED_BAR();
#pragma unroll
            for (int et = 0; et < 4; ++et)
#pragma unroll
                for (int dt = 0; dt < 2; ++dt) Sacc[dt][et] = __builtin_amdgcn_mfma_f32_16x16x32_bf16(cat8(ta[2 * dt], ta[2 * dt + 1]), cat8(tb[2 * et], tb[2 * et + 1]), Sacc[dt][et], 0, 0, 0);
            SCHED_BAR();
        }
        { const size_t row = R0 + qi; const float osc = exp2f(l2g * (float)(qi - 127)); float ssq = 0.f;
#pragma unroll
          for (int et = 0; et < 4; ++et) { O[et] = O[et] * osc; ssq += (O[et][0] * O[et][0] + O[et][1] * O[et][1]) + (O[et][2] * O[et][2] + O[et][3] * O[et][3]); }
          ssq += __shfl_xor(ssq, 16); ssq += __shfl_xor(ssq, 32);
          if (fq == 0) atomicAdd(rss + row * 4 + h, ssq);
#pragma unroll
          for (int et = 0; et < 4; ++et) { const u32x2 gw = Gc[et];
              u32x2 o; o.x = cvt_pk_bf16(O[et][0] * bflo(gw.x), O[et][1] * bfhi(gw.x)); o.y = cvt_pk_bf16(O[et][2] * bflo(gw.y), O[et][3] * bfhi(gw.y));
              *(u32x2*)((char*)proj + (R0 * DIN + VR_OFF + 512 * h + 64 * es + 16 * et) * 2 + offG) = o; } }
        LDS_BARRIER();
        if (c < 15) {
#pragma unroll
            for (int dt = 0; dt < 2; ++dt)
#pragma unroll
                for (int et = 0; et < 4; ++et) { u32x2 o; o.x = cvt_pk_bf16(Sacc[dt][et][0], Sacc[dt][et][1]); o.y = cvt_pk_bf16(Sacc[dt][et][2], Sacc[dt][et][3]);
                    *(LAS u32x2*)(ST + (16 * et + l16) * RS_P + (32 * w + 16 * dt + 4 * fq) * 2) = o; }
        }
    }
#undef RET_LOAD_KV
#undef RET_LOAD_QG
#pragma unroll
    for (int dt = 0; dt < 2; ++dt)
#pragma unroll
        for (int et = 0; et < 4; ++et)
#pragma unroll
            for (int jj = 0; jj < 4; ++jj)
                out[OFF_RP + ((size_t)bh * 256 + 32 * w + 16 * dt + 4 * fq + jj) * 512 + 64 * es + 16 * et + l16] = Sacc[dt][et][jj];
    if (same_xcd) { asm volatile("s_waitcnt vmcnt(0)" ::: "memory"); } else { __threadfence(); }
    __syncthreads();
    if (tid == 0) {
        __hip_atomic_fetch_add(cnt + bh, 1u, __ATOMIC_RELAXED, __HIP_MEMORY_SCOPE_AGENT);
        unsigned spins = 0;
        while (__hip_atomic_load(cnt + bh, __ATOMIC_RELAXED, __HIP_MEMORY_SCOPE_AGENT) < 8u) { __builtin_amdgcn_s_sleep(4); if (++spins > (1u << 22)) break; }
    }
    __syncthreads();
    if (!same_xcd) __builtin_amdgcn_fence(__ATOMIC_ACQUIRE, "agent");
#pragma unroll 1
    for (int it = 0; it < 4; ++it) { const size_t row = rowbase + tid + 512 * it;
        const float sq = __hip_atomic_load(rss + row * 4 + h, __ATOMIC_RELAXED, __HIP_MEMORY_SCOPE_AGENT);
        const float rs = rsqrtf(sq * (1.0f / 512.0f) + EPS);
        u32x4* up = (u32x4*)(proj + row * DIN + VR_OFF + 512 * h + 64 * es);
        u32x4 v[8];
#pragma unroll
        for (int pc = 0; pc < 8; ++pc) v[pc] = up[pc];
#pragma unroll
        for (int pc = 0; pc < 8; ++pc) { u32x4 o;
            o.x = cvt_pk_bf16(bflo(v[pc].x) * rs, bfhi(v[pc].x) * rs); o.y = cvt_pk_bf16(bflo(v[pc].y) * rs, bfhi(v[pc].y) * rs);
            o.z = cvt_pk_bf16(bflo(v[pc].z) * rs, bfhi(v[pc].z) * rs); o.w = cvt_pk_bf16(bflo(v[pc].w) * rs, bfhi(v[pc].w) * rs);
            up[pc] = o; } }
}

constexpr int AT_P = 144, AT_KI = 0, AT_VI = 39168;
__device__ __forceinline__ void attn_decode_it(int it, int& g, int& r, int& blk) {
    if (it < 16) { g = 0; r = 0; blk = it; } else if (it < 32) { g = 1; r = (it - 16) >> 2; blk = (it - 16) & 3; } else { g = 2; r = it - 32; blk = 0; }
}
__device__ __forceinline__ void attn_unit(LAS unsigned char* lds, bf16_t* proj, bf16_t* og, float* lse, int unit) {
    const int tid = threadIdx.x, lane = tid & 63, w = __builtin_amdgcn_readfirstlane(tid >> 6), l16 = lane & 15, fq = lane >> 4, tq = l16 >> 2, tp = l16 & 3;
    const int b = unit >> 3, h = unit & 7;
    LAS unsigned char* KI = lds + AT_KI; LAS unsigned char* VI = lds + AT_VI;
    __syncthreads();
    for (int i = tid; i < 272 * AT_P / 4; i += 512) { ((LAS unsigned*)KI)[i] = 0u; ((LAS unsigned*)VI)[i] = 0u; }
    const int qi = 16 * w + l16;
    u32x4 kreg[2], vreg[2]; bf16x8 Qn[2];
#define ATT_LOAD(it_) do { int g_, r_, blk_; attn_decode_it((it_), g_, r_, blk_); const int dil_ = 1 << (2 * g_); \
        _Pragma("unroll") for (int i_ = 0; i_ < 2; ++i_) { const int p_ = tid + 512 * i_, kc_ = p_ >> 3, pc_ = p_ & 7; \
            const bf16_t* base_ = proj + ((size_t)b * SEQ + (128 * blk_ + kc_) * dil_ + r_) * DIN + g_ * 512 + h * 64 + 8 * pc_; \
            kreg[i_] = *(const u32x4*)(base_ + KA_OFF); vreg[i_] = *(const u32x4*)(base_ + VA_OFF); } \
        { const bf16_t* qp_ = proj + ((size_t)b * SEQ + (128 * blk_ + qi) * dil_ + r_) * DIN + QA_OFF + g_ * 512 + h * 64 + 8 * fq; \
          Qn[0] = *(const bf16x8*)qp_; Qn[1] = *(const bf16x8*)(qp_ + 32); } } while (0)
    ATT_LOAD(0);
#pragma unroll 1
    for (int it = 0; it < 48; ++it) {
        int g, r, blk; attn_decode_it(it, g, r, blk); const int dil = 1 << (2 * g);
        const int par = it & 1;
        if (it == 32) { asm volatile("s_waitcnt vmcnt(0)" ::: "memory"); __syncthreads(); }
        LDS_BARRIER();
#pragma unroll
        for (int i = 0; i < 2; ++i) { const int p = tid + 512 * i, kc = p >> 3, pc = p & 7;
            *(LAS u32x4*)(KI + (par * 128 + kc) * AT_P + pc * 16) = kreg[i]; *(LAS u32x4*)(VI + (par * 128 + kc) * AT_P + pc * 16) = vreg[i]; }
        bf16x8 Qf[2]; Qf[0] = Qn[0]; Qf[1] = Qn[1];
        const int tokq = (128 * blk + qi) * dil + r; const size_t rowq = (size_t)b * SEQ + tokq;
        float l0 = 0.f, l1 = 0.f; u32x2 c0[4], c1[4];
#pragma unroll
        for (int et = 0; et < 4; ++et) { c0[et] = (u32x2){0u, 0u}; c1[et] = (u32x2){0u, 0u}; }
        SCHED_BAR();
        if (g == 2) {
            l0 = lse[((size_t)0 * 128 + unit) * SEQ + tokq]; l1 = lse[((size_t)1 * 128 + unit) * SEQ + tokq];
            const bf16_t* o0p = og + ((size_t)0 * MP + rowq) * 512 + h * 64 + 4 * fq; const bf16_t* o1p = og + ((size_t)1 * MP + rowq) * 512 + h * 64 + 4 * fq;
#pragma unroll
            for (int et = 0; et < 4; ++et) { c0[et] = *(const u32x2*)(o0p + 16 * et); c1[et] = *(const u32x2*)(o1p + 16 * et); }
        }
        SCHED_BAR();
        if (it + 1 < 48) ATT_LOAD(it + 1);
        SCHED_BAR();
        LDS_BARRIER();
#define ATT_TROW(T_) (((T_) < 8) ? ((1 - par) * 128 + 16 * (T_)) : ((T_) < 16) ? (par * 128 + 16 * ((T_) - 8)) : 256)
        f32x4 S[10]; float mx = -1e30f;
#pragma unroll
        for (int hb = 0; hb < 2; ++hb) { bf16x8 F[10];
#pragma unroll
            for (int k5 = 0; k5 < 5; ++k5) { if (5 * hb + k5 < 9) { const int tr0 = ATT_TROW(w + 5 * hb + k5);
#pragma unroll
                for (int ks = 0; ks < 2; ++ks) F[2 * k5 + ks] = *(const LAS bf16x8*)(KI + (tr0 + l16) * AT_P + (32 * ks + 8 * fq) * 2); } }
            SCHED_BAR();
#pragma unroll
            for (int k5 = 0; k5 < 5; ++k5) if (5 * hb + k5 < 9) S[5 * hb + k5] = __builtin_amdgcn_mfma_f32_16x16x32_bf16(F[2 * k5], Qf[0], (f32x4){0.f, 0.f, 0.f, 0.f}, 0, 0, 0);
#pragma unroll
            for (int k5 = 0; k5 < 5; ++k5) if (5 * hb + k5 < 9) S[5 * hb + k5] = __builtin_amdgcn_mfma_f32_16x16x32_bf16(F[2 * k5 + 1], Qf[1], S[5 * hb + k5], 0, 0, 0);
            SCHED_BAR(); }
#pragma unroll
        for (int kt = 0; kt < 10; ++kt) {
            if (kt == 9) { S[kt] = (f32x4){-1e30f, -1e30f, -1e30f, -1e30f}; }
            else {
                const bool tile_ok = (w + kt >= 8) || (blk > 0);
#pragma unroll
                for (int jj = 0; jj < 4; ++jj) {
                    const bool valid = (kt == 0) ? (tile_ok && (4 * fq + jj >= l16)) : (kt == 8) ? (tile_ok && (4 * fq + jj <= l16)) : tile_ok;
                    const float sv = valid ? S[kt][jj] : -1e30f; S[kt][jj] = sv; mx = fmaxf(mx, sv); } } }
        mx = fmaxf(mx, __shfl_xor(mx, 16)); mx = fmaxf(mx, __shfl_xor(mx, 32));
        float l = 0.f;
#pragma unroll
        for (int kt = 0; kt < 10; ++kt)
#pragma unroll
            for (int jj = 0; jj < 4; ++jj) { const float pv = __expf(S[kt][jj] - mx); S[kt][jj] = pv; l += pv; }
        l += __shfl_xor(l, 16); l += __shfl_xor(l, 32);
        f32x4 O[4];
#pragma unroll
        for (int et = 0; et < 4; ++et) O[et] = (f32x4){0.f, 0.f, 0.f, 0.f};
#pragma unroll
        for (int s5 = 0; s5 < 5; ++s5) { const bf16x8 Pf = pack8(S[2 * s5], S[2 * s5 + 1]); s16x4 tv[8];
            const int ra = ATT_TROW(w + 2 * s5), rb2 = ATT_TROW(w + 2 * s5 + 1);
#pragma unroll
            for (int et = 0; et < 4; ++et) { tv[2 * et] = trr(VI + (ra + 4 * fq + tq) * AT_P + (16 * et + 4 * tp) * 2);
                tv[2 * et + 1] = trr(VI + (rb2 + 4 * fq + tq) * AT_P + (16 * et + 4 * tp) * 2); }
            SCHED_BAR();
#pragma unroll
            for (int et = 0; et < 4; ++et) O[et] = __builtin_amdgcn_mfma_f32_16x16x32_bf16(cat8(tv[2 * et], tv[2 * et + 1]), Pf, O[et], 0, 0, 0);
            SCHED_BAR(); }
#undef ATT_TROW
        const float inv = 1.0f / l, lsv = mx + __logf(l);
        if (g < 2) {
            bf16_t* ogp = og + ((size_t)g * MP + rowq) * 512 + h * 64 + 4 * fq;
#pragma unroll
            for (int et = 0; et < 4; ++et) { u32x2 wv; wv.x = cvt_pk_bf16(O[et][0] * inv, O[et][1] * inv); wv.y = cvt_pk_bf16(O[et][2] * inv, O[et][3] * inv); *(u32x2*)(ogp + 16 * et) = wv; }
            if (fq == 0) lse[((size_t)g * 128 + unit) * SEQ + tokq] = lsv;
        } else {
            const float mm = fmaxf(lsv, fmaxf(l0, l1)); float w0 = __expf(l0 - mm), w1 = __expf(l1 - mm), w2 = __expf(lsv - mm); const float iv = 1.0f / (w0 + w1 + w2);
            w0 *= iv; w1 *= iv; w2 *= iv * inv;
            bf16_t* dst = proj + rowq * DIN + QA_OFF + h * 64 + 4 * fq;
#pragma unroll
            for (int et = 0; et < 4; ++et) { const u32x2 a0 = c0[et], a1 = c1[et];
                const float r0 = bflo(a0.x) * w0 + bflo(a1.x) * w1 + O[et][0] * w2, r1 = bfhi(a0.x) * w0 + bfhi(a1.x) * w1 + O[et][1] * w2;
                const float r2 = bflo(a0.y) * w0 + bflo(a1.y) * w1 + O[et][2] * w2, r3 = bfhi(a0.y) * w0 + bfhi(a1.y) * w1 + O[et][3] * w2;
                u32x2 wv; wv.x = cvt_pk_bf16(r0, r1); wv.y = cvt_pk_bf16(r2, r3); *(u32x2*)(dst + 16 * et) = wv; }
        }
    }
#undef ATT_LOAD
}

__device__ __forceinline__ float wave_max(float v) { for (int o = 1; o < 64; o <<= 1) v = fmaxf(v, __shfl_xor(v, o)); return v; }
__device__ __forceinline__ float wave_sum(float v) { for (int o = 1; o < 64; o <<= 1) v += __shfl_xor(v, o); return v; }
__device__ __forceinline__ void sample_attn_task(LAS float* qs, const Ptrs& P, bf16_t* proj, const float* kvnew, int task, int lane) {
    const int b = task >> 3, h = task & 7; const size_t row = (size_t)MPROMPT + b;
    float M = -1e30f, num = 0.f, den = 0.f;
#pragma unroll 1
    for (int g = 0; g < 3; ++g) {
        const int wb = 128 << (2 * g), dil = 1 << (2 * g); const float* cache = (g == 0) ? P.in[2] : (g == 1) ? P.in[3] : P.in[4];
        const float* kn = kvnew + (size_t)b * 3072 + g * 512 + h * 64;
        const float* cb = cache + (size_t)b * wb * 1024 + h * 64;
        { const unsigned short qv = proj[row * DIN + QA_OFF + g * 512 + h * 64 + lane]; qs[lane] = __uint_as_float((unsigned)qv << 16); }
        asm volatile("s_waitcnt lgkmcnt(0)" ::: "memory");
        float sc[3];
#pragma unroll
        for (int rnd = 0; rnd < 3; ++rnd) { const int j = lane + 64 * rnd; float s = -1e30f;
            if (j <= 128) { const float* kp = (j == 0) ? kn : cb + (size_t)(wb - dil * j) * 1024;
                s = 0.f;
#pragma unroll
                for (int d4 = 0; d4 < 16; ++d4) { const f32x4 kv = *(const f32x4*)(kp + 4 * d4); const f32x4 qv = *(const LAS f32x4*)(qs + 4 * d4);
                    s += (kv[0] * qv[0] + kv[1] * qv[1]) + (kv[2] * qv[2] + kv[3] * qv[3]); } }
            sc[rnd] = s; }
        const float mx = wave_max(fmaxf(sc[0], fmaxf(sc[1], sc[2])));
        float pr[3]; float l = 0.f;
#pragma unroll
        for (int rnd = 0; rnd < 3; ++rnd) { pr[rnd] = __expf(sc[rnd] - mx); l += pr[rnd]; }
        l = wave_sum(l);
        float o = __shfl(pr[0], 0) * kn[1536 + lane];
#pragma unroll 1
        for (int j0 = 1; j0 <= 128; j0 += 16) { float vv[16];
#pragma unroll
            for (int k = 0; k < 16; ++k) vv[k] = cb[(size_t)(wb - dil * (j0 + k)) * 1024 + 512 + lane];
#pragma unroll
            for (int k = 0; k < 16; ++k) { const int j = j0 + k; const float pj = __shfl(j < 64 ? pr[0] : j < 128 ? pr[1] : pr[2], j & 63); o += pj * vv[k]; } }
        const float og = o / l, ls = mx + __logf(l);
        const float Mn = fmaxf(M, ls), sa = __expf(M - Mn), sb = __expf(ls - Mn);
        num = num * sa + og * sb; den = den * sa + sb; M = Mn;
    }
    proj[row * DIN + QA_OFF + h * 64 + lane] = (bf16_t)(cvt_pk_bf16(num / den, 0.f) & 0xffffu);
}
__device__ __forceinline__ void sample_ret_unit(LAS unsigned char* lds, const Ptrs& P, bf16_t* proj, int unit) {
    const int tid = threadIdx.x, b = unit >> 2, h = unit & 3; const size_t row = (size_t)MPROMPT + b;
    const float gam = 1.0f - exp2f(-5.0f - (float)h);
    LAS float* qk = (LAS float*)lds;
    LAS float* red = (LAS float*)(lds + 4096);
    LAS float* wsum = (LAS float*)(lds + 4096 + 8192);
    __syncthreads();
    { const int i = tid & 255; const int off = (tid < 256) ? QR_OFF : KR_OFF; qk[tid] = __uint_as_float((unsigned)proj[row * DIN + off + 256 * h + i] << 16); }
    const int e4 = tid & 127, dg = tid >> 7;
    const u32x2 vw = *(const u32x2*)(proj + row * DIN + VR_OFF + 512 * h + 4 * e4);
    const f32x4 vv = {bflo(vw.x), bfhi(vw.x), bflo(vw.y), bfhi(vw.y)};
    __syncthreads();
    const float* s0 = P.in[5] + (size_t)unit * 256 * 512; float* s1 = P.out + OFF_RS + (size_t)unit * 256 * 512;
    f32x4 oacc = {0.f, 0.f, 0.f, 0.f};
#pragma unroll 4
    for (int it = 0; it < 64; ++it) { const int d = dg + 4 * it; const float kd = qk[256 + d], qd = qk[d];
        const f32x4 sn = *(const f32x4*)(s0 + (size_t)d * 512 + 4 * e4) * gam + vv * kd;
        *(f32x4*)(s1 + (size_t)d * 512 + 4 * e4) = sn; oacc += sn * qd; }
    *(LAS f32x4*)(red + dg * 512 + 4 * e4) = oacc;
    __syncthreads();
    const float o = (red[tid] + red[512 + tid]) + (red[1024 + tid] + red[1536 + tid]);
    const float ps = wave_sum(o * o);
    if ((tid & 63) == 0) wsum[tid >> 6] = ps;
    __syncthreads();
    float tot = 0.f;
#pragma unroll
    for (int i = 0; i < 8; ++i) tot += wsum[i];
    const float rs = rsqrtf(tot * (1.0f / 512.0f) + EPS);
    const float gv = __uint_as_float((unsigned)proj[row * DIN + GR_OFF + 512 * h + tid] << 16);
    proj[row * DIN + VR_OFF + 512 * h + tid] = (bf16_t)(cvt_pk_bf16(o * rs * gv, 0.f) & 0xffffu);
}


#define XB_TMO      128
#define XB_XCNT(j)  (256  + 64 * (j))
#define XB_XSUB(j)  (1280 + 64 * (j))
#define XB_XGEN(j)  (2304 + 64 * (j))
#define XB_TOP      3328
#define XB_TOPGEN   3392
#define XB_SPIN_CAP (1u << 18)
__device__ __forceinline__ unsigned xb_ld(unsigned* p)              { return __hip_atomic_load(p, __ATOMIC_RELAXED, __HIP_MEMORY_SCOPE_AGENT); }
__device__ __forceinline__ unsigned xb_add(unsigned* p, unsigned v) { return __hip_atomic_fetch_add(p, v, __ATOMIC_RELAXED, __HIP_MEMORY_SCOPE_AGENT); }
__device__ __forceinline__ unsigned xb_xcc_id() { return (unsigned)__builtin_amdgcn_s_getreg((3 << 11) | 20) & 0xFu; }
#define XB_SPIN(cond, bar) do { unsigned _sp = 0; while (cond) { __builtin_amdgcn_s_sleep(1); \
    if ((++_sp & 255u) == 0u) { if (xb_ld(&(bar)[XB_TMO])) break; if (_sp > XB_SPIN_CAP) { atomicAdd(&(bar)[XB_TMO], 1u); break; } } } } while (0)
struct XcdBarrier { unsigned* bar; unsigned x; volatile LAS unsigned* st; };
__device__ __forceinline__ XcdBarrier xcd_barrier_post(unsigned* bar, volatile LAS unsigned* st) {
    XcdBarrier b; b.bar = bar; b.x = xb_xcc_id(); b.st = st;
    if (threadIdx.x == 0) (void)xb_add(&bar[XB_XCNT(b.x)], 1u);
    return b;
}
__device__ __forceinline__ void xcd_barrier_complete(unsigned* bar, unsigned x, unsigned& nloc, unsigned& nx) {
    const unsigned G = gridDim.x * gridDim.y * gridDim.z;
    unsigned sum, cnt, mine, sp = 0u;
    for (;;) {
        sum = 0u; cnt = 0u; mine = 0u;
#pragma unroll
        for (unsigned j = 0; j < 16; ++j) { const unsigned c = xb_ld(&bar[XB_XCNT(j)]); sum += c; cnt += (c > 0u) ? 1u : 0u; mine = (j == x) ? c : mine; }
        if (sum == G) break;
        __builtin_amdgcn_s_sleep(1);
        if ((++sp & 255u) == 0u) { if (xb_ld(&bar[XB_TMO])) break; if (sp > XB_SPIN_CAP) { atomicAdd(&bar[XB_TMO], 1u); break; } }
    }
    nloc = mine > 0u ? mine : 1u; nx = cnt > 0u ? cnt : 1u;
}
__device__ __forceinline__ void xcd_barrier(const XcdBarrier& b) {
    asm volatile("s_waitcnt vmcnt(0)" ::: "memory");
    __syncthreads();
    if (threadIdx.x == 0) {
        unsigned* bar = b.bar;
        __builtin_amdgcn_s_waitcnt(0);
        unsigned nloc = b.st[0], nx = b.st[1];
        if (nloc == 0u) { xcd_barrier_complete(bar, b.x, nloc, nx); b.st[0] = nloc; b.st[1] = nx; }
        const unsigned old = xb_add(&bar[XB_XSUB(b.x)], 1u);
        const unsigned gen = old / nloc;
        if (old + 1u == (gen + 1u) * nloc) {
            __builtin_amdgcn_fence(__ATOMIC_RELEASE, "agent");
            asm volatile("s_waitcnt vmcnt(0)" ::: "memory");
            const unsigned og = xb_add(&bar[XB_TOP], 1u);
            const unsigned tg = og / nx;
            if (og + 1u == (tg + 1u) * nx) xb_add(&bar[XB_TOPGEN], 1u);
            else XB_SPIN(xb_ld(&bar[XB_TOPGEN]) == tg, bar);
            __builtin_amdgcn_fence(__ATOMIC_ACQUIRE, "agent");
            xb_add(&bar[XB_XGEN(b.x)], 1u);
            asm volatile("s_waitcnt vmcnt(0)" ::: "memory");
        } else {
            XB_SPIN(xb_ld(&bar[XB_XGEN(b.x)]) == gen, bar);
            __builtin_amdgcn_fence(__ATOMIC_ACQUIRE, "agent");
            asm volatile("s_waitcnt vmcnt(0)" ::: "memory");
        }
    }
    __syncthreads();
}

__global__ void __launch_bounds__(512, 2) fwd_megakernel(Ptrs P) {
    extern __shared__ __attribute__((aligned(16))) unsigned char lds_raw[];
    LAS unsigned char* lds = (LAS unsigned char*)lds_raw;
    cg::grid_group grid = cg::this_grid();
    const int tid = threadIdx.x, lane = tid & 63, wave = __builtin_amdgcn_readfirstlane(tid >> 6);
    const int G = gridDim.x, bx = blockIdx.x;
    unsigned char* ws = P.ws;
    if (tid < 2) ((LAS unsigned*)(lds + 135168 + 64))[tid] = 0u;
    __syncthreads();
    const XcdBarrier xbar = xcd_barrier_post((unsigned*)(ws + WS_BAR), (volatile LAS unsigned*)(lds + 135168 + 64));
    float* SS0 = (float*)(ws + WS_SS0); float* SS1 = (float*)(ws + WS_SS1); float* SS2 = (float*)(ws + WS_SS2); float* RSS = (float*)(ws + WS_RSS);
    unsigned* CNT = (unsigned*)(ws + WS_CNT);
    float* ROPE = (float*)(ws + WS_ROPE); float* RROT = (float*)(ws + WS_RROT);
    bf16_t* W1T = (bf16_t*)(ws + WS_W1T); bf16_t* W2T = (bf16_t*)(ws + WS_W2T); bf16_t* WINT = (bf16_t*)(ws + WS_WINT); bf16_t* WPAT = (bf16_t*)(ws + WS_WPAT);
    bf16_t* WPBT = (bf16_t*)(ws + WS_WPBT); bf16_t* WOT = (bf16_t*)(ws + WS_WOT); bf16_t* W3T = (bf16_t*)(ws + WS_W3T); bf16_t* W4T = (bf16_t*)(ws + WS_W4T);
    bf16_t* XB = (bf16_t*)(ws + WS_XB); float* KVNEW = (float*)(ws + WS_KVNEW); bf16_t* PROJ = (bf16_t*)(ws + WS_PROJ); bf16_t* ACT = (bf16_t*)(ws + WS_ACT); bf16_t* X2B = (bf16_t*)(ws + WS_X2B);

    {
        LAS float* scr = (LAS float*)(lds + wave * 16896);
        const int gw = bx * 8 + wave, NGW = G * 8;
        constexpr int I1 = 16 * 88, I2 = 44 * 16, I3 = 16 * 200, I4 = 8 * 16, I5 = 32 * 16, I6 = 16 * 16;
        constexpr int NITEMS = 2 * I1 + 2 * I2 + I3 + I4 + I5 + I6;
        for (int it = gw; it < NITEMS; it += NGW) {
            int r = it;
            if (r < I3) { p0_transpose_item(P.in[10], 1024, DIN, WINT, 2, P.in[9], scr, r, 200, lane); continue; } r -= I3;
            if (r < I1) { p0_transpose_item(P.in[7], 1024, 5632, W1T, 3, P.in[6], scr, r, 88, lane); continue; } r -= I1;
            if (r < I1) { p0_transpose_item(P.in[17], 1024, 5632, W3T, 3, P.in[16], scr, r, 88, lane); continue; } r -= I1;
            if (r < I2) { p0_transpose_item(P.in[8], DFF, 1024, W2T, 2, nullptr, scr, r, 16, lane); continue; } r -= I2;
            if (r < I2) { p0_transpose_item(P.in[18], DFF, 1024, W4T, 2, nullptr, scr, r, 16, lane); continue; } r -= I2;
            if (r < I4) { p0_transpose_item(P.in[13], 512, 1024, WPAT, 2, nullptr, scr, r, 16, lane); continue; } r -= I4;
            if (r < I5) { p0_transpose_item(P.in[14], 2048, 1024, WPBT, 2, nullptr, scr, r, 16, lane); continue; } r -= I5;
            p0_transpose_item(P.in[15], 1024, 1024, WOT, 2, nullptr, scr, r, 16, lane);
        }
        for (int row0 = gw; row0 < MP; row0 += 2 * NGW) {
            f32x4 v[2][4]; bool okr[2]; int rws[2];
#pragma unroll
            for (int q = 0; q < 2; ++q) { const int row = row0 + q * NGW; rws[q] = row; okr[q] = row < MREAL;
                const f32x4* xr = (const f32x4*)xin_row(P, okr[q] ? row : 0) + lane;
#pragma unroll
                for (int j = 0; j < 4; ++j) v[q][j] = xr[64 * j]; }
            SCHED_BAR();
#pragma unroll
            for (int q = 0; q < 2; ++q) { const int row = rws[q];
                if (row < MP) {
                    unsigned long long* o8 = (unsigned long long*)(XB + (size_t)row * DM) + lane;
                    if (okr[q]) { float sq = 0.f;
#pragma unroll
                        for (int j = 0; j < 4; ++j) sq += (v[q][j][0] * v[q][j][0] + v[q][j][1] * v[q][j][1]) + (v[q][j][2] * v[q][j][2] + v[q][j][3] * v[q][j][3]);
                        sq = wave_sum(sq);
#pragma unroll
                        for (int j = 0; j < 4; ++j) o8[64 * j] = (unsigned long long)cvt_pk_bf16(v[q][j][0], v[q][j][1]) | ((unsigned long long)cvt_pk_bf16(v[q][j][2], v[q][j][3]) << 32);
                        if (lane == 0) SS0[row] = sq;
                    } else {
#pragma unroll
                        for (int j = 0; j < 4; ++j) o8[64 * j] = 0ull;
                    }
                } }
        }
        const int gt = bx * 512 + tid, NGT = G * 512;
        for (int i = gt; i < 2049 * 136; i += NGT) { const int p = i / 136, f = i % 136; const float pos = (p < 2048) ? (float)p : 16384.0f;
            double inv; float* dst;
            if (f < 8) { inv = my_exp(-(double)f / 8.0 * 13.122363377404328); dst = ROPE + ((size_t)p * 8 + f) * 2; }
            else { const int q = f - 8; inv = my_exp(-(double)q / 127.0 * 9.210340371976184); dst = RROT + ((size_t)p * 128 + q) * 2; }
            const float ang = pos * (float)inv; double s, c; my_sincos((double)ang, s, c); dst[0] = (float)c; dst[1] = (float)s; }
    }
    grid.sync();

    pg8::StaticOrder S;
    { pg8::Gemm g{XB, W1T, DM, MP, 5632, 1024, 0}; S.init(MPROMPT, 5632, G, bx); EpiSwiglu E{ACT, SS0}; pg8::gemm_phase(lds, g, S, E); skinny_phase(lds, g, E, G, bx); }
    xcd_barrier(xbar);
    { pg8::Gemm g{ACT, W2T, DFF, MP, 1024, DFF, 1}; S.init(MPROMPT, 1024, G, bx); EpiResid<0> E{P, XB, SS1}; pg8::gemm_phase(lds, g, S, E); skinny_phase(lds, g, E, G, bx); }
    xcd_barrier(xbar);
    { pg8::Gemm g{XB, WINT, DM, MP, DIN, 1024, 0}; S.init(MPROMPT, DIN, G, bx); EpiProj E{P, PROJ, SS1, ROPE, RROT, KVNEW}; pg8::gemm_phase(lds, g, S, E); skinny_phase(lds, g, E, G, bx); }
    xcd_barrier(xbar);
    {
        if (G == 256) {
            const int xcd = bx & 7, slot = bx >> 3;
            for (int rnd = 0; rnd < 2; ++rnd) ret_unit(lds, PROJ, P.out, RSS, CNT, rnd * 256 + ((xcd * 4 + (slot >> 3)) * 8 + (slot & 7)), true);
        } else {
            for (int u = bx; u < 512; u += G) ret_unit(lds, PROJ, P.out, RSS, CNT, u, false);
        }
        for (int u = bx; u < 128; u += G) attn_unit(lds, PROJ, (bf16_t*)(ws + WS_OG), (float*)(ws + WS_LSE), u);
        const int rb = G - 1 - bx;
        for (int u = rb; u < 128; u += G) sample_ret_unit(lds, P, PROJ, u);
        __syncthreads();
        for (int t = rb * 8 + wave; t < 256; t += G * 8) sample_attn_task((LAS float*)(lds + 16384 + wave * 256), P, PROJ, KVNEW, t, lane);
        { const int ncw = (G > 128) ? (G - 128) : G;
          if (rb < ncw) {
            const size_t gt = (size_t)rb * 512 + tid, NGT = (size_t)ncw * 512;
#pragma unroll 1
            for (int g = 0; g < 3; ++g) { const int lw = 7 + 2 * g, wb = 1 << lw;
                const f32x4* src = (const f32x4*)(g == 0 ? P.in[2] : g == 1 ? P.in[3] : P.in[4]); f32x4* dst = (f32x4*)(P.out + (g == 0 ? OFF_KVS0 : g == 1 ? OFF_KVS1 : OFF_KVS2));
                const size_t total = (size_t)NSAMP << (lw + 8);
                for (size_t i0 = gt; i0 < total; i0 += 8 * NGT) {
                    f32x4 v[8];
#pragma unroll
                    for (int k = 0; k < 8; ++k) { const size_t i = i0 + (size_t)k * NGT;
                        if (i < total) { const int rowi = (int)(i >> 8) & (wb - 1);
                            if (rowi < wb - 1) v[k] = __builtin_nontemporal_load(src + i + 256);
                            else { const int bb = (int)(i >> (lw + 8)), c4 = (int)(i & 255), sx = c4 >> 7, hh = (c4 >> 4) & 7, d4 = c4 & 15;
                                v[k] = *(const f32x4*)(KVNEW + (size_t)bb * 3072 + sx * 1536 + g * 512 + hh * 64 + d4 * 4); } } }
#pragma unroll
                    for (int k = 0; k < 8; ++k) { const size_t i = i0 + (size_t)k * NGT; if (i < total) __builtin_nontemporal_store(v[k], dst + i); }
                } } } }
    }
    xcd_barrier(xbar);
    { pg8::Gemm g{PROJ + QA_OFF, WPAT, DIN, MP, 1024, 512, 0}; S.init(MPROMPT, 1024, G, bx); EpiGate1 E{PROJ}; pg8::gemm_phase(lds, g, S, E); skinny_phase(lds, g, E, G, bx); }
    { pg8::Gemm g{PROJ + VR_OFF, WPBT, DIN, MP, 1024, 2048, 0}; S.init(MPROMPT, 1024, G, bx); EpiGate2 E{PROJ, XB}; pg8::gemm_phase(lds, g, S, E); skinny_phase(lds, g, E, G, bx); }
    xcd_barrier(xbar);
    { pg8::Gemm g{XB, WOT, DM, MP, 1024, 1024, 0}; S.init(MPROMPT, 1024, G, bx); EpiResid<1> E{P, X2B, SS2}; pg8::gemm_phase(lds, g, S, E); skinny_phase(lds, g, E, G, bx); }
    xcd_barrier(xbar);
    { pg8::Gemm g{X2B, W3T, DM, MP, 5632, 1024, 0}; S.init(MPROMPT, 5632, G, bx); EpiSwiglu E{ACT, SS2}; pg8::gemm_phase(lds, g, S, E); skinny_phase(lds, g, E, G, bx); }
    xcd_barrier(xbar);
    { pg8::Gemm g{ACT, W4T, DFF, MP, 1024, DFF, 1}; S.init(MPROMPT, 1024, G, bx); EpiResid<2> E{P, nullptr, nullptr}; pg8::gemm_phase(lds, g, S, E); skinny_phase(lds, g, E, G, bx); }
}

extern "C" void kernel_launch(void* const* d_in, const int* in_sizes, int n_in, void* d_out, int out_size, void* d_ws, size_t ws_size, hipStream_t stream) {
    static int grid = 0;
    if (grid == 0) {
        int dev = 0, cus = 0, per_cu = 0;
        hipGetDevice(&dev);
        hipDeviceGetAttribute(&cus, hipDeviceAttributeMultiprocessorCount, dev);
        hipFuncSetAttribute((const void*)fwd_megakernel, hipFuncAttributeMaxDynamicSharedMemorySize, LDS_BYTES);
        hipOccupancyMaxActiveBlocksPerMultiprocessor(&per_cu, (const void*)fwd_megakernel, 512, LDS_BYTES);
        if (per_cu < 1) { fprintf(stderr, "kernel_launch: occupancy query says %d blocks/CU\n", per_cu); per_cu = 1; }
        grid = cus * per_cu; if (grid > 256) grid = 256; grid &= ~7;
        if (n_in != 19 || ws_size < WS_END) fprintf(stderr, "kernel_launch: unexpected n_in %d / ws_size %zu (need %zu)\n", n_in, ws_size, (size_t)WS_END);
    }
    hipMemsetAsync(d_ws, 0, CTL_BYTES, stream);
    Ptrs p{};
    for (int i = 0; i < 19; ++i) p.in[i] = (const float*)d_in[i];
    p.out = (float*)d_out; p.ws = (unsigned char*)d_ws;
    void* args[] = {&p};
    hipError_t e = hipLaunchCooperativeKernel((const void*)fwd_megakernel, dim3(grid), dim3(512), args, LDS_BYTES, stream);
    if (e != hipSuccess) fprintf(stderr, "cooperative launch failed: %s (grid %d)\n", hipGetErrorString(e), grid);
}
```

```cpp
#include <hip/hip_runtime.h>
#include <hip/hip_cooperative_groups.h>
#include <cstdio>
#include <cstdint>
namespace cg = cooperative_groups;

#define LAS __attribute__((address_space(3)))
typedef unsigned short bf16_t;
typedef short bf16x8 __attribute__((ext_vector_type(8)));
typedef short s16x4 __attribute__((ext_vector_type(4)));
typedef float f32x4 __attribute__((ext_vector_type(4)));
typedef unsigned u32x4 __attribute__((ext_vector_type(4)));
typedef unsigned u32x2 __attribute__((ext_vector_type(2)));

constexpr int DM = 1024, SEQ = 2048, NBATCH = 16, MPROMPT = NBATCH * SEQ, NSAMP = 32, MREAL = MPROMPT + NSAMP, MP = MPROMPT + 256;
constexpr int DFF = 2816, DIN = 12800;
constexpr int QA_OFF = 0, KA_OFF = 1536, VA_OFF = 3072, QR_OFF = 4608, KR_OFF = 5632, VR_OFF = 6656, GR_OFF = 8704, GA_OFF = 10752, GB_OFF = 11776;
constexpr float EPS = 1e-6f;
constexpr size_t OFF_Y = 0, OFF_YS = 33554432, OFF_KVP0 = 33587200, OFF_KVP1 = 35684352, OFF_KVP2 = 44072960, OFF_RP = 77627392,
                 OFF_KVS0 = 86016000, OFF_KVS1 = 90210304, OFF_KVS2 = 106987520, OFF_RS = 174096384;
constexpr int M32_COL = 512;
constexpr size_t MiB = 1u << 20;
constexpr size_t WS_SS0 = 0, WS_SS1 = 192 * 1024, WS_SS2 = 384 * 1024, WS_RSS = 576 * 1024, WS_CNT = 1536 * 1024, CTL_BYTES = 2 * MiB;
constexpr size_t WS_BAR = 1600 * 1024;
constexpr size_t WS_ROPE = 2 * MiB, WS_RROT = 2 * MiB + 256 * 1024;
constexpr size_t WS_W1T = 8 * MiB, WS_W2T = 19 * MiB, WS_WINT = 25 * MiB, WS_WPAT = 50 * MiB, WS_WPBT = 51 * MiB, WS_WOT = 55 * MiB, WS_W3T = 57 * MiB, WS_W4T = 68 * MiB;
constexpr size_t WS_XB = 74 * MiB, WS_XS = 139 * MiB, WS_KVNEW = 140 * MiB, WS_PROJ = 141 * MiB;
constexpr size_t WS_ACT = WS_PROJ, WS_X2B = WS_PROJ + 200 * MiB;
constexpr size_t WS_OG = WS_XB;
constexpr size_t WS_LSE = WS_W1T;
constexpr size_t WS_END = WS_PROJ + (size_t)MP * DIN * 2;
static_assert(WS_END <= 1024 * MiB, "ws map");
static_assert(WS_XB + (size_t)MP * DM * 2 <= WS_XS, "ws map xb");
constexpr int LDS_BYTES = 147456;

__device__ __forceinline__ unsigned cvt_pk_bf16(float lo, float hi) { unsigned r; asm volatile("v_cvt_pk_bf16_f32 %0, %1, %2" : "=v"(r) : "v"(lo), "v"(hi)); return r; }
__device__ __forceinline__ float bflo(unsigned w) { return __uint_as_float(w << 16); }
__device__ __forceinline__ float bfhi(unsigned w) { return __uint_as_float(w & 0xffff0000u); }
__device__ __forceinline__ float fast_sigmoid(float a) { return __builtin_amdgcn_rcpf(1.0f + __expf(-a)); }
__device__ __forceinline__ bf16x8 cat8(s16x4 a, s16x4 b) { return __builtin_shufflevector(a, b, 0, 1, 2, 3, 4, 5, 6, 7); }
__device__ __forceinline__ s16x4 trr(LAS unsigned char* p) { return __builtin_amdgcn_ds_read_tr16_b64_v4i16((LAS s16x4*)p); }
#define SCHED_BAR() __builtin_amdgcn_sched_barrier(0)
#define LDS_BARRIER() do { asm volatile("s_waitcnt lgkmcnt(0)" ::: "memory"); __builtin_amdgcn_s_barrier(); asm volatile("" ::: "memory"); } while (0)
__device__ __forceinline__ bf16x8 pack8(const f32x4& a, const f32x4& b) {
    u32x4 w; w.x = cvt_pk_bf16(a[0], a[1]); w.y = cvt_pk_bf16(a[2], a[3]); w.z = cvt_pk_bf16(b[0], b[1]); w.w = cvt_pk_bf16(b[2], b[3]);
    return __builtin_bit_cast(bf16x8, w);
}

struct Ptrs {
    const float* in[19];
    float* out;
    unsigned char* ws;
};
__device__ __forceinline__ const float* xin_row(const Ptrs& P, int row) { return row < MPROMPT ? P.in[0] + (size_t)row * DM : P.in[1] + (size_t)(row - MPROMPT) * DM; }
__device__ __forceinline__ float* x1_row(const Ptrs& P, int row) { return row < MPROMPT ? P.out + OFF_Y + (size_t)row * DM : (float*)(P.ws + WS_XS) + (size_t)(row - MPROMPT) * DM; }
__device__ __forceinline__ float* y_row(const Ptrs& P, int row) { return row < MPROMPT ? P.out + OFF_Y + (size_t)row * DM : P.out + OFF_YS + (size_t)(row - MPROMPT) * DM; }

namespace pg8 {
constexpr int BM = 256, BK = 64, HALF = 128, HTB = HALF * BK * 2, STAGE_BYTES = 8 * HTB, NXCD = 8, WGM = 8;
__host__ __device__ __forceinline__ int lds_byte(int r, int c) { const int st = (r >> 4) * 2 + (c >> 5), rr = r & 15, cc = c & 31, ob = rr * 64 + cc * 2; return st * 1024 + (ob ^ (((ob >> 9) & 1) << 5)); }
__host__ __device__ __forceinline__ void stage_rc(int b, int& R, int& C) { const int st = b / 1024, sb = b % 1024, swz = sb ^ (((sb >> 9) & 1) << 5); R = (st >> 1) * 16 + swz / 64; C = (st & 1) * 32 + (swz % 64) / 2; }
struct Unit { int pm, pn; };
struct Gemm { const bf16_t* A; const bf16_t* Bt; int lda, M, N, K; int a_tiled; };
struct StaticOrder {
    int nM, nN, nwg, G, c;
    __device__ void init(int M, int N, int G_, int c_) { nM = M / BM; nN = N / BM; nwg = nM * nN; G = G_; c = c_; }
    __device__ bool next(int i, Unit& u) const {
        const long L = (long)i * G + c; if (L >= nwg) return false;
        int wgid = (int)L; { const int q = nwg / NXCD, r = nwg % NXCD, xcd = wgid % NXCD, off = wgid / NXCD; wgid = (xcd < r ? xcd * (q + 1) : r * (q + 1) + (xcd - r) * q) + off; }
        const int nig = WGM * nN, gid = wgid / nig, fm = gid * WGM, gsz = (nM - fm) < WGM ? (nM - fm) : WGM;
        u.pm = fm + ((wgid % nig) % gsz); u.pn = (wgid % nig) / gsz; return true;
    }
};
template <class Epi>
__device__ __forceinline__ void gemm_phase(LAS unsigned char* lds, const Gemm g, const StaticOrder& S, const Epi& E) {
    int tid = threadIdx.x; asm volatile("" : "+v"(tid));
    const int wid = __builtin_amdgcn_readfirstlane(tid >> 6), lane = tid & 63, wr = wid >> 2, wc = wid & 3, fr = lane & 15, fq = lane >> 4;
    const int K = g.K, nt = K / BK;
    unsigned voffA[2], voffB[2];
#pragma unroll
    for (int i = 0; i < 2; ++i) { int R, C; stage_rc(tid * 16 + i * 8192, R, C); voffA[i] = (unsigned)(R * (g.a_tiled ? BK : g.lda) + C) * 2u; voffB[i] = (unsigned)(R * K + C) * 2u; }
    const size_t kstep = (size_t)(BK * 2);
    const size_t kstepA = g.a_tiled ? (size_t)(BM * BK * 2) : kstep;
    const size_t hstepA = g.a_tiled ? (size_t)(HALF * BK * 2) : (size_t)HALF * g.lda * 2, tstepA = g.a_tiled ? (size_t)nt * BM * BK * 2 : 2 * hstepA, hstepB = (size_t)HALF * K * 2, tstepB = 2 * hstepB;
    const unsigned ldsw = (unsigned)wid * 1024u;
    const int aoff = lds_byte(wr * 64 + fr, fq * 8), boff = lds_byte(wc * 32 + fr, fq * 8);
#define PG8_SA(b, h) (((b) * 2 + (h)) * HTB)
#define PG8_SB(b, h) ((4 + (b) * 2 + (h)) * HTB)
#define PG8_STAGE(bufoff, gbase, voff) do { _Pragma("unroll") for (int _i = 0; _i < 2; ++_i) \
        __builtin_amdgcn_global_load_lds((const unsigned*)((const char*)(gbase) + (voff)[_i]), (LAS unsigned*)(lds + (bufoff) + ldsw + _i * 8192), 16, 0, 0); } while (0)
#define PG8_LDA(dst, b, h) do { _Pragma("unroll") for (int m = 0; m < 4; ++m) _Pragma("unroll") for (int k = 0; k < 2; ++k) dst[m][k] = *(const LAS bf16x8*)(lds + PG8_SA(b, h) + aoff + m * 2048 + k * 1024); } while (0)
#define PG8_LDB(dst, b, h) do { _Pragma("unroll") for (int n = 0; n < 2; ++n) _Pragma("unroll") for (int k = 0; k < 2; ++k) dst[n][k] = *(const LAS bf16x8*)(lds + PG8_SB(b, h) + boff + n * 2048 + k * 1024); } while (0)
#define PG8_MMA(ai, bj, At, Bt) do { __builtin_amdgcn_s_setprio(1); _Pragma("unroll") for (int m = 0; m < 4; ++m) _Pragma("unroll") for (int n = 0; n < 2; ++n) _Pragma("unroll") for (int k = 0; k < 2; ++k) \
        acc[ai][bj][m][n] = __builtin_amdgcn_mfma_f32_16x16x32_bf16(Bt[n][k], At[m][k], acc[ai][bj][m][n], 0, 0, 0); __builtin_amdgcn_s_setprio(0); } while (0)
#define PG8_WAIT_V(n) asm volatile("s_waitcnt vmcnt(" #n ")" ::: "memory")
#define PG8_WAIT_L(n) asm volatile("s_waitcnt lgkmcnt(" #n ")" ::: "memory")
#define PG8_BAR __builtin_amdgcn_s_barrier()
#define PG8_SCHED __builtin_amdgcn_sched_barrier(0)
    Unit cur, nxt; int ui = 0;
    if (!S.next(0, cur)) return;
    f32x4 acc[2][2][4][2];
#pragma unroll
    for (int a = 0; a < 2; ++a)
#pragma unroll
        for (int b = 0; b < 2; ++b)
#pragma unroll
            for (int m = 0; m < 4; ++m)
#pragma unroll
                for (int n = 0; n < 2; ++n) acc[a][b][m][n] = (f32x4){0.f, 0.f, 0.f, 0.f};
    bf16x8 At[4][2], B0[2][2], B1[2][2];
    const char* cA = (const char*)g.A + (size_t)cur.pm * tstepA; const char* cB = (const char*)g.Bt + (size_t)cur.pn * tstepB;
    PG8_STAGE(PG8_SB(0, 0), cB, voffB); PG8_STAGE(PG8_SB(0, 1), cB + hstepB, voffB); PG8_STAGE(PG8_SA(0, 0), cA, voffA); PG8_STAGE(PG8_SA(0, 1), cA + hstepA, voffA);
    if (wr == 1) PG8_BAR;
    PG8_WAIT_V(2); PG8_BAR;
    PG8_STAGE(PG8_SB(1, 0), cB + kstep, voffB); PG8_STAGE(PG8_SA(1, 0), cA + kstepA, voffA); PG8_STAGE(PG8_SB(1, 1), cB + hstepB + kstep, voffB);
    PG8_WAIT_V(6); PG8_BAR;
    for (;;) {
        const bool has_next = S.next(ui + 1, nxt);
        const char* nA = has_next ? (const char*)g.A + (size_t)nxt.pm * tstepA : cA; const char* nB = has_next ? (const char*)g.Bt + (size_t)nxt.pn * tstepB : cB;
        for (int t = 0; t < nt; t += 2) {
            const bool last = (t == nt - 2);
            const char* a1 = cA + (size_t)(t + 1) * kstepA;
            const char* a2 = last ? nA : cA + (size_t)(t + 2) * kstepA; const char* b2 = last ? nB : cB + (size_t)(t + 2) * kstep;
            const char* a3 = a2 + kstepA; const char* b3 = b2 + kstep;
            PG8_LDB(B0, 0, 0); PG8_LDB(B1, 0, 1); PG8_SCHED; PG8_LDA(At, 0, 0); PG8_STAGE(PG8_SA(1, 1), a1 + hstepA, voffA);
            PG8_WAIT_V(8); PG8_WAIT_L(0); PG8_BAR; PG8_MMA(0, 0, At, B0); PG8_MMA(0, 1, At, B1); PG8_BAR; PG8_SCHED;
            PG8_LDA(At, 0, 1); PG8_STAGE(PG8_SB(0, 0), b2, voffB); PG8_STAGE(PG8_SB(0, 1), b2 + hstepB, voffB); PG8_STAGE(PG8_SA(0, 0), a2, voffA);
            PG8_WAIT_V(8); PG8_WAIT_L(0); PG8_BAR; PG8_MMA(1, 0, At, B0); PG8_MMA(1, 1, At, B1); PG8_BAR; PG8_SCHED;
            PG8_LDB(B0, 1, 0); PG8_LDB(B1, 1, 1); PG8_SCHED; PG8_LDA(At, 1, 0); PG8_STAGE(PG8_SA(0, 1), a2 + hstepA, voffA);
            PG8_WAIT_V(8); PG8_WAIT_L(0); PG8_BAR; PG8_MMA(0, 0, At, B0); PG8_MMA(0, 1, At, B1); PG8_BAR; PG8_SCHED;
            PG8_LDA(At, 1, 1); PG8_STAGE(PG8_SB(1, 0), b3, voffB); PG8_STAGE(PG8_SB(1, 1), b3 + hstepB, voffB); PG8_STAGE(PG8_SA(1, 0), a3, voffA);
            PG8_WAIT_V(8); PG8_WAIT_L(0); PG8_BAR; PG8_MMA(1, 0, At, B0); PG8_MMA(1, 1, At, B1); PG8_BAR; PG8_SCHED;
        }
        if (wr == 0) PG8_BAR;
        E(acc, cur, wr, wc, fr, fq);
        if (!has_next) break;
#pragma unroll
        for (int a = 0; a < 2; ++a)
#pragma unroll
            for (int b = 0; b < 2; ++b)
#pragma unroll
                for (int m = 0; m < 4; ++m)
#pragma unroll
                    for (int n = 0; n < 2; ++n) acc[a][b][m][n] = (f32x4){0.f, 0.f, 0.f, 0.f};
        cur = nxt; cA = nA; cB = nB; ++ui;
        if (wr == 1) PG8_BAR;
    }
    PG8_WAIT_V(0);
    PG8_BAR;
#undef PG8_SA
#undef PG8_SB
#undef PG8_STAGE
#undef PG8_LDA
#undef PG8_LDB
#undef PG8_MMA
#undef PG8_WAIT_V
#undef PG8_WAIT_L
#undef PG8_BAR
#undef PG8_SCHED
}
}
using pg8::Unit;
typedef f32x4 Acc[2][2][4][2];

struct EpiSwiglu {
    bf16_t* act; const float* ss;
    __device__ __forceinline__ void operator()(const Acc& acc, const Unit& u, int wr, int wc, int fr, int fq) const {
        float ssv[2][4];
#pragma unroll
        for (int ai = 0; ai < 2; ++ai)
#pragma unroll
            for (int m = 0; m < 4; ++m) ssv[ai][m] = ss[u.pm * 256 + ai * 128 + wr * 64 + m * 16 + fr];
        SCHED_BAR();
#pragma unroll
        for (int ai = 0; ai < 2; ++ai)
#pragma unroll
            for (int m = 0; m < 4; ++m) {
                const int row = u.pm * 256 + ai * 128 + wr * 64 + m * 16 + fr;
                const float rs = rsqrtf(ssv[ai][m] * (1.0f / DM) + EPS);
                bf16_t* dst = act + ((size_t)((row >> 8) * (DFF / 64) + u.pn * 2 + (wc >> 1)) * 256 + (row & 255)) * 64 + (wc & 1) * 32 + fq * 8;
                u32x4 w;
#pragma unroll
                for (int n = 0; n < 2; ++n) {
                    const f32x4 a = acc[ai][0][m][n] * rs, b = acc[ai][1][m][n] * rs; f32x4 v;
#pragma unroll
                    for (int j = 0; j < 4; ++j) v[j] = a[j] * fast_sigmoid(a[j]) * b[j];
                    if (n == 0) { w.x = cvt_pk_bf16(v[0], v[1]); w.y = cvt_pk_bf16(v[2], v[3]); } else { w.z = cvt_pk_bf16(v[0], v[1]); w.w = cvt_pk_bf16(v[2], v[3]); }
                }
                *(u32x4*)dst = w;
            }
    }
};
template <int MODE> struct EpiResid {
    Ptrs P; bf16_t* xb; float* ssn;
    __device__ __forceinline__ void operator()(const Acc& acc, const Unit& u, int wr, int wc, int fr, int fq) const {
        const float sc = (MODE == 1) ? 1.0f : 0.5f;
        const int colb = u.pn * 256 + wc * 64 + fq * 8;
#pragma unroll
        for (int ai = 0; ai < 2; ++ai) {
            f32x4 R[4][2][2];
#pragma unroll
            for (int m = 0; m < 4; ++m) {
                const int row = u.pm * 256 + ai * 128 + wr * 64 + m * 16 + fr; const int rr = row < MREAL ? row : 0;
                const float* res = ((MODE == 0) ? xin_row(P, rr) : (const float*)x1_row(P, rr)) + colb;
#pragma unroll
                for (int bj = 0; bj < 2; ++bj)
#pragma unroll
                    for (int n = 0; n < 2; ++n) R[m][bj][n] = *(const f32x4*)(res + bj * 32 + n * 4);
            }
            SCHED_BAR();
#pragma unroll
            for (int m = 0; m < 4; ++m) {
                const int row = u.pm * 256 + ai * 128 + wr * 64 + m * 16 + fr;
                const bool ok = row < MREAL; const int rr = ok ? row : 0;
                float* dst = ((MODE == 2) ? y_row(P, rr) : x1_row(P, rr)) + colb;
                float part = 0.f;
#pragma unroll
                for (int bj = 0; bj < 2; ++bj) {
                    const f32x4 o0 = R[m][bj][0] + acc[ai][bj][m][0] * sc, o1 = R[m][bj][1] + acc[ai][bj][m][1] * sc;
                    if (ok) {
                        *(f32x4*)(dst + bj * 32) = o0; *(f32x4*)(dst + bj * 32 + 4) = o1;
                        if (MODE != 2) { part += ((o0[0] * o0[0] + o0[1] * o0[1]) + (o0[2] * o0[2] + o0[3] * o0[3])) + ((o1[0] * o1[0] + o1[1] * o1[1]) + (o1[2] * o1[2] + o1[3] * o1[3]));
                            u32x4 w; w.x = cvt_pk_bf16(o0[0], o0[1]); w.y = cvt_pk_bf16(o0[2], o0[3]); w.z = cvt_pk_bf16(o1[0], o1[1]); w.w = cvt_pk_bf16(o1[2], o1[3]);
                            *(u32x4*)(xb + (size_t)row * DM + colb + bj * 32) = w; }
                    }
                }
                if (MODE != 2) { part += __shfl_xor(part, 16); part += __shfl_xor(part, 32); if (ok && fq == 0) atomicAdd(ssn + row, part); }
            }
        }
    }
};
struct EpiProj {
    Ptrs P; bf16_t* proj; const float* ss1; const float* rope; const float* rrot; float* kvnew;
    __device__ __forceinline__ void operator()(const Acc& acc, const Unit& u, int wr, int wc, int fr, int fq) const {
        const int pn = u.pn;
        const int kind = pn < 6 ? 0 : pn < 12 ? 1 : pn < 18 ? 2 : pn < 22 ? 3 : pn < 26 ? 4 : pn < 34 ? 5 : pn < 42 ? 6 : 7;
        const float* gp = P.in[kind == 0 ? 11 : 12];
#pragma unroll
        for (int ai = 0; ai < 2; ++ai)
#pragma unroll
            for (int m = 0; m < 4; ++m) {
                const int row = u.pm * 256 + ai * 128 + wr * 64 + m * 16 + fr;
                const float rs = rsqrtf(ss1[row] * (1.0f / DM) + EPS);
                const int posidx = row < MPROMPT ? (row & 2047) : 2048;
                f32x4 v[2][2];
#pragma unroll
                for (int bj = 0; bj < 2; ++bj)
#pragma unroll
                    for (int n = 0; n < 2; ++n) v[bj][n] = acc[ai][bj][m][n] * rs;
                if (kind <= 1) {
                    float s2 = 0.f;
#pragma unroll
                    for (int bj = 0; bj < 2; ++bj)
#pragma unroll
                        for (int n = 0; n < 2; ++n) s2 += (v[bj][n][0] * v[bj][n][0] + v[bj][n][1] * v[bj][n][1]) + (v[bj][n][2] * v[bj][n][2] + v[bj][n][3] * v[bj][n][3]);
                    s2 += __shfl_xor(s2, 16); s2 += __shfl_xor(s2, 32);
                    const float r = rsqrtf(s2 * (1.0f / 64.0f) + EPS);
#pragma unroll
                    for (int bj = 0; bj < 2; ++bj)
#pragma unroll
                        for (int n = 0; n < 2; ++n) { const f32x4 gv = *(const f32x4*)(gp + bj * 32 + fq * 8 + n * 4); v[bj][n] = v[bj][n] * r * gv; }
#pragma unroll
                    for (int n = 0; n < 2; ++n) { const f32x4 csa = *(const f32x4*)(rope + ((size_t)posidx * 8 + 4 * n) * 2), csb = *(const f32x4*)(rope + ((size_t)posidx * 8 + 4 * n) * 2 + 4);
                        const float cc[4] = {csa[0], csa[2], csb[0], csb[2]}, sn[4] = {csa[1], csa[3], csb[1], csb[3]};
#pragma unroll
                        for (int j = 0; j < 4; ++j) { const float mine = v[0][n][j], other = __shfl_xor(mine, 16);
                            const float rot = (fq == 0) ? (mine * cc[j] - other * sn[j]) : (mine * cc[j] + other * sn[j]);
                            v[0][n][j] = (fq < 2) ? rot : mine; } }
                    if (kind == 0) {
#pragma unroll
                        for (int bj = 0; bj < 2; ++bj)
#pragma unroll
                            for (int n = 0; n < 2; ++n) v[bj][n] = v[bj][n] * 0.125f;
                    }
                } else if (kind == 3 || kind == 4) {
                    const float ksc = (kind == 4) ? 0.0625f : 1.0f;
#pragma unroll
                    for (int bj = 0; bj < 2; ++bj)
#pragma unroll
                        for (int n = 0; n < 2; ++n) {
                            const int i0 = (wc * 64 + bj * 32 + fq * 8 + n * 4) >> 1;
                            const f32x4 cs = *(const f32x4*)(rrot + ((size_t)posidx * 128 + i0) * 2);
                            const f32x4 x = v[bj][n]; f32x4 o;
                            o[0] = (x[0] * cs[0] - x[1] * cs[1]) * ksc; o[1] = (x[1] * cs[0] + x[0] * cs[1]) * ksc;
                            o[2] = (x[2] * cs[2] - x[3] * cs[3]) * ksc; o[3] = (x[3] * cs[2] + x[2] * cs[3]) * ksc;
                            v[bj][n] = o;
                        }
                } else if (kind == 6) {
#pragma unroll
                    for (int bj = 0; bj < 2; ++bj)
#pragma unroll
                        for (int n = 0; n < 2; ++n)
#pragma unroll
                            for (int j = 0; j < 4; ++j) { const float a = v[bj][n][j]; v[bj][n][j] = a * fast_sigmoid(a); }
                } else if (kind == 7) {
#pragma unroll
                    for (int bj = 0; bj < 2; ++bj)
#pragma unroll
                        for (int n = 0; n < 2; ++n)
#pragma unroll
                            for (int j = 0; j < 4; ++j) v[bj][n][j] = fast_sigmoid(v[bj][n][j]);
                }
                bf16_t* dst = proj + (size_t)row * DIN + pn * 256 + wc * 64 + fq * 8;
#pragma unroll
                for (int bj = 0; bj < 2; ++bj) { u32x4 w; w.x = cvt_pk_bf16(v[bj][0][0], v[bj][0][1]); w.y = cvt_pk_bf16(v[bj][0][2], v[bj][0][3]);
                    w.z = cvt_pk_bf16(v[bj][1][0], v[bj][1][1]); w.w = cvt_pk_bf16(v[bj][1][2], v[bj][1][3]); *(u32x4*)(dst + bj * 32) = w; }
                if (kind == 1 || kind == 2) {
                    const int s = kind - 1, pq = pn - (kind == 1 ? 6 : 12), gi = pq >> 1, hh = (pq & 1) * 4 + wc;
                    float* o32 = nullptr;
                    if (row < MPROMPT) {
                        const int b = row >> 11, t = row & 2047, keep = 128 << (2 * gi), tt = t - (SEQ - keep);
                        if (tt >= 0) { const size_t base = gi == 0 ? OFF_KVP0 : gi == 1 ? OFF_KVP1 : OFF_KVP2;
                            o32 = P.out + base + ((((size_t)b * keep + tt) * 2 + s) * 8 + hh) * 64 + fq * 8; }
                    } else if (row < MREAL) {
                        o32 = kvnew + (size_t)(row - MPROMPT) * 3072 + s * 1536 + gi * 512 + hh * 64 + fq * 8;
                    }
                    if (o32) {
#pragma unroll
                        for (int bj = 0; bj < 2; ++bj)
#pragma unroll
                            for (int n = 0; n < 2; ++n) *(f32x4*)(o32 + bj * 32 + n * 4) = v[bj][n];
                    }
                }
            }
    }
};
struct EpiGate1 {
    bf16_t* proj;
    __device__ __forceinline__ void operator()(const Acc& acc, const Unit& u, int wr, int wc, int fr, int fq) const {
        const int colb = u.pn * 256 + wc * 64 + fq * 8;
        u32x4 Gt[2][4][2];
#pragma unroll
        for (int ai = 0; ai < 2; ++ai)
#pragma unroll
            for (int m = 0; m < 4; ++m) { const int row = u.pm * 256 + ai * 128 + wr * 64 + m * 16 + fr; const bf16_t* gp = proj + (size_t)row * DIN + GA_OFF + colb;
#pragma unroll
                for (int bj = 0; bj < 2; ++bj) Gt[ai][m][bj] = *(const u32x4*)(gp + bj * 32); }
        SCHED_BAR();
#pragma unroll
        for (int ai = 0; ai < 2; ++ai)
#pragma unroll
            for (int m = 0; m < 4; ++m) { const int row = u.pm * 256 + ai * 128 + wr * 64 + m * 16 + fr; float* mp = (float*)(proj + (size_t)row * DIN + M32_COL) + colb;
#pragma unroll
                for (int bj = 0; bj < 2; ++bj) { const u32x4 gw = Gt[ai][m][bj];
                    const f32x4 g0 = {bflo(gw.x), bfhi(gw.x), bflo(gw.y), bfhi(gw.y)}, g1 = {bflo(gw.z), bfhi(gw.z), bflo(gw.w), bfhi(gw.w)};
                    *(f32x4*)(mp + bj * 32) = acc[ai][bj][m][0] * g0; *(f32x4*)(mp + bj * 32 + 4) = acc[ai][bj][m][1] * g1; } }
    }
};
struct EpiGate2 {
    const bf16_t* proj; bf16_t* mb;
    __device__ __forceinline__ void operator()(const Acc& acc, const Unit& u, int wr, int wc, int fr, int fq) const {
        const int colb = u.pn * 256 + wc * 64 + fq * 8;
#pragma unroll
        for (int ai = 0; ai < 2; ++ai)
#pragma unroll
            for (int mh = 0; mh < 2; ++mh) {
                u32x4 Gt[2][2]; f32x4 Mv[2][2][2];
#pragma unroll
                for (int m2 = 0; m2 < 2; ++m2) { const int row = u.pm * 256 + ai * 128 + wr * 64 + (2 * mh + m2) * 16 + fr;
                    const bf16_t* gp = proj + (size_t)row * DIN + GB_OFF + colb; const float* mp = (const float*)(proj + (size_t)row * DIN + M32_COL) + colb;
#pragma unroll
                    for (int bj = 0; bj < 2; ++bj) { Gt[m2][bj] = *(const u32x4*)(gp + bj * 32); Mv[m2][bj][0] = *(const f32x4*)(mp + bj * 32); Mv[m2][bj][1] = *(const f32x4*)(mp + bj * 32 + 4); } }
                SCHED_BAR();
#pragma unroll
                for (int m2 = 0; m2 < 2; ++m2) { const int m = 2 * mh + m2; const int row = u.pm * 256 + ai * 128 + wr * 64 + m * 16 + fr;
#pragma unroll
                    for (int bj = 0; bj < 2; ++bj) { const u32x4 gw = Gt[m2][bj];
                        const f32x4 g0 = {bflo(gw.x), bfhi(gw.x), bflo(gw.y), bfhi(gw.y)}, g1 = {bflo(gw.z), bfhi(gw.z), bflo(gw.w), bfhi(gw.w)};
                        const f32x4 o0 = Mv[m2][bj][0] + acc[ai][bj][m][0] * g0, o1 = Mv[m2][bj][1] + acc[ai][bj][m][1] * g1;
                        u32x4 w; w.x = cvt_pk_bf16(o0[0], o0[1]); w.y = cvt_pk_bf16(o0[2], o0[3]); w.z = cvt_pk_bf16(o1[0], o1[1]); w.w = cvt_pk_bf16(o1[2], o1[3]);
                        *(u32x4*)(mb + (size_t)row * DM + colb + bj * 32) = w; } }
                SCHED_BAR();
            }
    }
};

template <class Epi>
__device__ __forceinline__ void skinny_phase(LAS unsigned char* lds, const pg8::Gemm g, const Epi& E, int G, int bx) {
    int tid = threadIdx.x; asm volatile("" : "+v"(tid));
    const int wid = __builtin_amdgcn_readfirstlane(tid >> 6), lane = tid & 63, fr = lane & 15, fq = lane >> 4;
    const int nT = (g.N / 256) * 4, K = g.K, KS = K / 8;
    for (int task = G - 1 - bx; task < nT; task += G) {
        const int pn = task >> 2, wc = task & 3;
        f32x4 a8[2][2][2];
#pragma unroll
        for (int b = 0; b < 2; ++b)
#pragma unroll
            for (int m = 0; m < 2; ++m)
#pragma unroll
                for (int n = 0; n < 2; ++n) a8[b][m][n] = (f32x4){0.f, 0.f, 0.f, 0.f};
        const bf16_t* bp = g.Bt + (size_t)(256 * pn + 32 * wc + fr) * K + 8 * fq;
        const bf16_t* apl = g.a_tiled ? g.A + ((size_t)128 * (K / 64)) * (256 * 64) + (size_t)fr * 64 + 8 * fq : g.A + (size_t)(MPROMPT + fr) * g.lda + 8 * fq;
        const size_t am = g.a_tiled ? (size_t)16 * 64 : (size_t)16 * g.lda;
        const int kend = (wid + 1) * KS;
#pragma unroll 1
        for (int k0 = wid * KS; k0 < kend; k0 += 128) {
            bf16x8 Af[4][2], Bf[4][2][2];
#pragma unroll
            for (int kk = 0; kk < 4; ++kk) { const int k = k0 + 32 * kk;
                if (k < kend) {
                    const bf16_t* ak = g.a_tiled ? apl + (size_t)(k >> 6) * (256 * 64) + (k & 63) : apl + k;
#pragma unroll
                    for (int m = 0; m < 2; ++m) Af[kk][m] = *(const bf16x8*)(ak + m * am);
#pragma unroll
                    for (int bj = 0; bj < 2; ++bj)
#pragma unroll
                        for (int n = 0; n < 2; ++n) Bf[kk][bj][n] = *(const bf16x8*)(bp + (size_t)(128 * bj + 16 * n) * K + k);
                } else {
#pragma unroll
                    for (int m = 0; m < 2; ++m) Af[kk][m] = (bf16x8){0, 0, 0, 0, 0, 0, 0, 0};
#pragma unroll
                    for (int bj = 0; bj < 2; ++bj)
#pragma unroll
                        for (int n = 0; n < 2; ++n) Bf[kk][bj][n] = (bf16x8){0, 0, 0, 0, 0, 0, 0, 0};
                } }
            SCHED_BAR();
#pragma unroll
            for (int kk = 0; kk < 4; ++kk)
#pragma unroll
                for (int bj = 0; bj < 2; ++bj)
#pragma unroll
                    for (int n = 0; n < 2; ++n)
#pragma unroll
                        for (int m = 0; m < 2; ++m) a8[bj][m][n] = __builtin_amdgcn_mfma_f32_16x16x32_bf16(Bf[kk][bj][n], Af[kk][m], a8[bj][m][n], 0, 0, 0);
            SCHED_BAR();
        }
        LAS f32x4* red = (LAS f32x4*)lds;
        __syncthreads();
#pragma unroll
        for (int b = 0; b < 2; ++b)
#pragma unroll
            for (int m = 0; m < 2; ++m)
#pragma unroll
                for (int n = 0; n < 2; ++n) red[(((b * 2 + m) * 2 + n) * 8 + wid) * 64 + lane] = a8[b][m][n];
        __syncthreads();
        if (wid == 0) {
            Acc acc;
#pragma unroll
            for (int a = 0; a < 2; ++a)
#pragma unroll
                for (int b = 0; b < 2; ++b)
#pragma unroll
                    for (int m = 0; m < 4; ++m)
#pragma unroll
                        for (int n = 0; n < 2; ++n) acc[a][b][m][n] = (f32x4){0.f, 0.f, 0.f, 0.f};
#pragma unroll
            for (int b = 0; b < 2; ++b)
#pragma unroll
                for (int m = 0; m < 2; ++m)
#pragma unroll
                    for (int n = 0; n < 2; ++n) { f32x4 t = {0.f, 0.f, 0.f, 0.f};
#pragma unroll
                        for (int w8 = 0; w8 < 8; ++w8) t += red[(((b * 2 + m) * 2 + n) * 8 + w8) * 64 + lane];
                        acc[0][b][m][n] = t; SCHED_BAR(); }
#pragma unroll
            for (int a = 0; a < 2; ++a)
#pragma unroll
                for (int b = 0; b < 2; ++b)
#pragma unroll
                    for (int m = 0; m < 4; ++m)
#pragma unroll
                        for (int n = 0; n < 2; ++n) asm volatile("" : "+v"(acc[a][b][m][n]));
            const Unit u{128, pn};
            E(acc, u, 0, wc, fr, fq);
        }
        __syncthreads();
    }
}

__device__ __forceinline__ void p0_transpose_item(const float* W, int K, int Nsrc, bf16_t* WT, int mode, const float* gain, LAS float* scr, int item, int nblk, int lane) {
    const int kb = item / nblk, nb2 = item % nblk, k0 = 64 * kb;
    const int g32 = 2 * nb2 + (lane >> 5);
    const int tile = g32 >> 3, within = g32 & 7, bj = within >> 2, wc = within & 3;
    const int nsrc = (((mode & 1) == 0) ? (tile * 256 + 64 * wc + 32 * bj) : ((bj ? DFF : 0) + tile * 128 + 32 * wc)) + (lane & 31);
    float v[64];
#pragma unroll
    for (int i = 0; i < 64; ++i) v[i] = W[(size_t)(k0 + i) * Nsrc + nsrc];
#pragma unroll
    for (int i = 0; i < 64; ++i) scr[i * 65 + lane] = v[i] * (gain ? gain[k0 + i] : 1.0f);
    asm volatile("s_waitcnt lgkmcnt(0)" ::: "memory");
    const int c = lane & 7;
#pragma unroll
    for (int j = 0; j < 8; ++j) { const int n = (lane >> 3) + 8 * j, wi = n & 31; const int ns = (n & 32) + ((mode & 2) ? (8 * ((wi >> 2) & 3) + 4 * (wi >> 4) + (wi & 3)) : wi);
        const LAS float* sp = scr + (8 * c) * 65 + ns;
        u32x4 o; o.x = cvt_pk_bf16(sp[0 * 65], sp[1 * 65]); o.y = cvt_pk_bf16(sp[2 * 65], sp[3 * 65]); o.z = cvt_pk_bf16(sp[4 * 65], sp[5 * 65]); o.w = cvt_pk_bf16(sp[6 * 65], sp[7 * 65]);
        *(u32x4*)(WT + (size_t)(nb2 * 64 + n) * K + k0 + 8 * c) = o; }
    asm volatile("s_waitcnt lgkmcnt(0)" ::: "memory");
}
__device__ __forceinline__ double my_exp(double x) {
    const double LN2 = 0.6931471805599453094; const double n = __builtin_rint(x / LN2); const double r = x - n * LN2;
    double t = 1.0; for (int k = 16; k >= 1; --k) t = 1.0 + t * r / (double)k;
    const long long e = (long long)n + 1023; return t * __builtin_bit_cast(double, (unsigned long long)e << 52);
}
__device__ __forceinline__ void my_sincos(double a, double& s, double& c) {
    const double TWO_PI = 6.283185307179586476925; const double n = __builtin_rint(a / TWO_PI); const double r = __builtin_fma(-n, 2.4492935982947064e-16, a - n * 6.283185307179586);
    const double r2 = r * r; double ts = 1.0, tc = 1.0;
    for (int k = 14; k >= 1; --k) { ts = 1.0 - ts * r2 / (double)((2 * k) * (2 * k + 1)); tc = 1.0 - tc * r2 / (double)((2 * k - 1) * (2 * k)); }
    s = r * ts; c = tc;
}

__device__ __forceinline__ float ret_l2g(int h) { return h == 0 ? -0.04580368961312479f : h == 1 ? -0.02272007650008353f : h == 2 ? -0.011315313227834146f : -0.005646563141142063f; }
constexpr int RK_P = 560, RS_P = 528, RV_P = 144, R_KI = 0, R_ST = 71680, R_VI = 105472;
__device__ __forceinline__ void ret_unit(LAS unsigned char* lds, bf16_t* proj, float* out, float* rss, unsigned* cnt, int unit, bool same_xcd) {
    const int tid = threadIdx.x, lane = tid & 63, w = __builtin_amdgcn_readfirstlane(tid >> 6), l16 = lane & 15, fq = lane >> 4, tq = l16 >> 2, tp = l16 & 3;
    const int bh = unit >> 3, es = unit & 7, b = bh >> 2, h = bh & 3;
    const float l2g = ret_l2g(h), g128 = exp2f(l2g * 128.0f);
    LAS unsigned char* KI = lds + R_KI; LAS unsigned char* ST = lds + R_ST; LAS unsigned char* VI = lds + R_VI;
    __syncthreads();
    for (int i = tid; i < 33792 / 4; i += 512) ((LAS unsigned*)ST)[i] = 0u;
    f32x4 Sacc[2][4];
#pragma unroll
    for (int dt = 0; dt < 2; ++dt)
#pragma unroll
        for (int et = 0; et < 4; ++et) Sacc[dt][et] = (f32x4){0.f, 0.f, 0.f, 0.f};
    const size_t rowbase = (size_t)b * SEQ;
    const int wq = (w < 4) ? w : 11 - w;
    const int qi = 16 * wq + l16;
    u32x4 Kn[8], Vn[2]; bf16x8 Qn[8]; u32x2 Gn[4];
    const unsigned offK = (unsigned)((tid >> 5) * DIN + 8 * (tid & 31)) * 2u, offV = (unsigned)((tid >> 3) * DIN + 8 * (tid & 7)) * 2u;
    const unsigned offQ = (unsigned)(qi * DIN + 8 * fq) * 2u, offG = (unsigned)(qi * DIN + 4 * fq) * 2u;
    const char* pb = (const char*)proj;
#define RET_LOAD_KV(c_) do { const size_t ub_ = (rowbase + 128 * (size_t)(c_)) * DIN * 2; \
        _Pragma("unroll") for (int it_ = 0; it_ < 8; ++it_) Kn[it_] = *(const u32x4*)(pb + (ub_ + ((size_t)(16 * it_) * DIN + KR_OFF + 256 * h) * 2) + offK); \
        _Pragma("unroll") for (int it_ = 0; it_ < 2; ++it_) Vn[it_] = *(const u32x4*)(pb + (ub_ + ((size_t)(64 * it_) * DIN + VR_OFF + 512 * h + 64 * es) * 2) + offV); } while (0)
#define RET_LOAD_QG(c_) do { const size_t ub_ = (rowbase + 128 * (size_t)(c_)) * DIN * 2; \
        _Pragma("unroll") for (int ks_ = 0; ks_ < 8; ++ks_) Qn[ks_] = *(const bf16x8*)(pb + (ub_ + (size_t)(QR_OFF + 256 * h + 32 * ks_) * 2) + offQ); \
        _Pragma("unroll") for (int et_ = 0; et_ < 4; ++et_) Gn[et_] = *(const u32x2*)(pb + (ub_ + (size_t)(GR_OFF + 512 * h + 64 * es + 16 * et_) * 2) + offG); } while (0)
    RET_LOAD_KV(0); RET_LOAD_QG(0);
#pragma unroll 1
    for (int c = 0; c < 16; ++c) {
        const size_t R0 = rowbase + 128 * c;
#pragma unroll
        for (int it = 0; it < 8; ++it) { const int p = tid + 512 * it; *(LAS u32x4*)(KI + (p >> 5) * RK_P + (p & 31) * 16) = Kn[it]; }
#pragma unroll
        for (int it = 0; it < 2; ++it) { const int p = tid + 512 * it, j = p >> 3, pc = p & 7; const u32x4 v = Vn[it];
            const float sc = exp2f(l2g * (float)(127 - j));
            u32x4 o; o.x = cvt_pk_bf16(bflo(v.x) * sc, bfhi(v.x) * sc); o.y = cvt_pk_bf16(bflo(v.y) * sc, bfhi(v.y) * sc);
            o.z = cvt_pk_bf16(bflo(v.z) * sc, bfhi(v.z) * sc); o.w = cvt_pk_bf16(bflo(v.w) * sc, bfhi(v.w) * sc);
            *(LAS u32x4*)(VI + j * RV_P + pc * 16) = o; }
        bf16x8 Qf[8]; u32x2 Gc[4];
#pragma unroll
        for (int ks = 0; ks < 8; ++ks) Qf[ks] = Qn[ks];
#pragma unroll
        for (int et = 0; et < 4; ++et) Gc[et] = Gn[et];
        SCHED_BAR();
        if (c < 15) RET_LOAD_KV(c + 1);
        SCHED_BAR();
        LDS_BARRIER();
        f32x4 O[4];
#pragma unroll
        for (int et = 0; et < 4; ++et) O[et] = (f32x4){0.f, 0.f, 0.f, 0.f};
#pragma unroll
        for (int ks = 0; ks < 8; ++ks) { bf16x8 F[4];
#pragma unroll
            for (int et = 0; et < 4; ++et) F[et] = *(const LAS bf16x8*)(ST + (16 * et + l16) * RS_P + (32 * ks + 8 * fq) * 2);
            SCHED_BAR();
#pragma unroll
            for (int et = 0; et < 4; ++et) O[et] = __builtin_amdgcn_mfma_f32_16x16x32_bf16(F[et], Qf[ks], O[et], 0, 0, 0);
            SCHED_BAR(); }
#pragma unroll
        for (int et = 0; et < 4; ++et) O[et] = O[et] * g128;
#pragma unroll
        for (int s = 0; s < 4; ++s) {
            if (2 * s <= wq) {
                f32x4 T0 = {0.f, 0.f, 0.f, 0.f}, T1 = {0.f, 0.f, 0.f, 0.f};
                const bool two = (2 * s + 1 <= wq);
#pragma unroll
                for (int hb = 0; hb < 2; ++hb) { bf16x8 F[8];
#pragma unroll
                    for (int k4 = 0; k4 < 4; ++k4) { F[k4] = *(const LAS bf16x8*)(KI + (32 * s + l16) * RK_P + (32 * (4 * hb + k4) + 8 * fq) * 2);
                        F[4 + k4] = *(const LAS bf16x8*)(KI + (32 * s + 16 + l16) * RK_P + (32 * (4 * hb + k4) + 8 * fq) * 2); }
                    SCHED_BAR();
#pragma unroll
                    for (int k4 = 0; k4 < 4; ++k4) { T0 = __builtin_amdgcn_mfma_f32_16x16x32_bf16(F[k4], Qf[4 * hb + k4], T0, 0, 0, 0);
                        if (two) T1 = __builtin_amdgcn_mfma_f32_16x16x32_bf16(F[4 + k4], Qf[4 * hb + k4], T1, 0, 0, 0); }
                    SCHED_BAR(); }
                s16x4 tv[8];
#pragma unroll
                for (int et = 0; et < 4; ++et) { tv[2 * et] = trr(VI + (32 * s + 4 * fq + tq) * RV_P + (16 * et + 4 * tp) * 2);
                    tv[2 * et + 1] = trr(VI + (32 * s + 16 + 4 * fq + tq) * RV_P + (16 * et + 4 * tp) * 2); }
#pragma unroll
                for (int jj = 0; jj < 4; ++jj) { if (32 * s + 4 * fq + jj > qi) T0[jj] = 0.f; if (!two || 32 * s + 16 + 4 * fq + jj > qi) T1[jj] = 0.f; }
                const bf16x8 Pf = pack8(T0, T1);
                SCHED_BAR();
#pragma unroll
                for (int et = 0; et < 4; ++et) O[et] = __builtin_amdgcn_mfma_f32_16x16x32_bf16(cat8(tv[2 * et], tv[2 * et + 1]), Pf, O[et], 0, 0, 0);
                SCHED_BAR();
            }
        }
        SCHED_BAR();
        if (c < 15) RET_LOAD_QG(c + 1);
        SCHED_BAR();
#pragma unroll
        for (int dt = 0; dt < 2; ++dt)
#pragma unroll
            for (int et = 0; et < 4; ++et) Sacc[dt][et] = Sacc[dt][et] * g128;
#pragma unroll
        for (int s = 0; s < 4; ++s) {
            s16x4 ta[4], tb[8];
#pragma unroll
            for (int dt = 0; dt < 2; ++dt) { ta[2 * dt] = trr(KI + (32 * s + 8 * fq + tq) * RK_P + (32 * w + 16 * dt + 4 * tp) * 2);
                ta[2 * dt + 1] = trr(KI + (32 * s + 8 * fq + 4 + tq) * RK_P + (32 * w + 16 * dt + 4 * tp) * 2); }
#pragma unroll
            for (int et = 0; et < 4; ++et) { tb[2 * et] = trr(VI + (32 * s + 8 * fq + tq) * RV_P + (16 * et + 4 * tp) * 2);
                tb[2 * et + 1] = trr(VI + (32 * s + 8 * fq + 4 + tq) * RV_P + (16 * et + 4 * tp) * 2); }
            SCHED_BAR();
#pragma unroll
            for (int et = 0; et < 4; ++et)
#pragma unroll
                for (int dt = 0; dt < 2; ++dt) Sacc[dt][et] = __builtin_amdgcn_mfma_f32_16x16x32_bf16(cat8(ta[2 * dt], ta[2 * dt + 1]), cat8(tb[2 * et], tb[2 * et + 1]), Sacc[dt][et], 0, 0, 0);
            SCHED_BAR();
        }
        { const size_t row = R0 + qi; const float osc = exp2f(l2g * (float)(qi - 127)); float ssq = 0.f;
#pragma unroll
          for (int et = 0; et < 4; ++et) { O[et] = O[et] * osc; ssq += (O[et][0] * O[et][0] + O[et][1] * O[et][1]) + (O[et][2] * O[et][2] + O[et][3] * O[et][3]); }
          ssq += __shfl_xor(ssq, 16); ssq += __shfl_xor(ssq, 32);
          if (fq == 0) atomicAdd(rss + row * 4 + h, ssq);
#pragma unroll
          for (int et = 0; et < 4; ++et) { const u32x2 gw = Gc[et];
              u32x2 o; o.x = cvt_pk_bf16(O[et][0] * bflo(gw.x), O[et][1] * bfhi(gw.x)); o.y = cvt_pk_bf16(O[et][2] * bflo(gw.y), O[et][3] * bfhi(gw.y));
              *(u32x2*)((char*)proj + (R0 * DIN + VR_OFF + 512 * h + 64 * es + 16 * et) * 2 + offG) = o; } }
        LDS_BARRIER();
        if (c < 15) {
#pragma unroll
            for (int dt = 0; dt < 2; ++dt)
#pragma unroll
                for (int et = 0; et < 4; ++et) { u32x2 o; o.x = cvt_pk_bf16(Sacc[dt][et][0], Sacc[dt][et][1]); o.y = cvt_pk_bf16(Sacc[dt][et][2], Sacc[dt][et][3]);
                    *(LAS u32x2*)(ST + (16 * et + l16) * RS_P + (32 * w + 16 * dt + 4 * fq) * 2) = o; }
        }
    }
#undef RET_LOAD_KV
#undef RET_LOAD_QG
#pragma unroll
    for (int dt = 0; dt < 2; ++dt)
#pragma unroll
        for (int et = 0; et < 4; ++et)
#pragma unroll
            for (int jj = 0; jj < 4; ++jj)
                out[OFF_RP + ((size_t)bh * 256 + 32 * w + 16 * dt + 4 * fq + jj) * 512 + 64 * es + 16 * et + l16] = Sacc[dt][et][jj];
    if (same_xcd) { asm volatile("s_waitcnt vmcnt(0)" ::: "memory"); } else { __threadfence(); }
    __syncthreads();
    if (tid == 0) {
        __hip_atomic_fetch_add(cnt + bh, 1u, __ATOMIC_RELAXED, __HIP_MEMORY_SCOPE_AGENT);
        unsigned spins = 0;
        while (__hip_atomic_load(cnt + bh, __ATOMIC_RELAXED, __HIP_MEMORY_SCOPE_AGENT) < 8u) { __builtin_amdgcn_s_sleep(4); if (++spins > (1u << 22)) break; }
    }
    __syncthreads();
    if (!same_xcd) __builtin_amdgcn_fence(__ATOMIC_ACQUIRE, "agent");
#pragma unroll 1
    for (int it = 0; it < 4; ++it) { const size_t row = rowbase + tid + 512 * it;
        const float sq = __hip_atomic_load(rss + row * 4 + h, __ATOMIC_RELAXED, __HIP_MEMORY_SCOPE_AGENT);
        const float rs = rsqrtf(sq * (1.0f / 512.0f) + EPS);
        u32x4* up = (u32x4*)(proj + row * DIN + VR_OFF + 512 * h + 64 * es);
        u32x4 v[8];
#pragma unroll
        for (int pc = 0; pc < 8; ++pc) v[pc] = up[pc];
#pragma unroll
        for (int pc = 0; pc < 8; ++pc) { u32x4 o;
            o.x = cvt_pk_bf16(bflo(v[pc].x) * rs, bfhi(v[pc].x) * rs); o.y = cvt_pk_bf16(bflo(v[pc].y) * rs, bfhi(v[pc].y) * rs);
            o.z = cvt_pk_bf16(bflo(v[pc].z) * rs, bfhi(v[pc].z) * rs); o.w = cvt_pk_bf16(bflo(v[pc].w) * rs, bfhi(v[pc].w) * rs);
            up[pc] = o; } }
}

constexpr int AT_P = 144, AT_KI = 0, AT_VI = 39168;
__device__ __forceinline__ void attn_decode_it(int it, int& g, int& r, int& blk) {
    if (it < 16) { g = 0; r = 0; blk = it; } else if (it < 32) { g = 1; r = (it - 16) >> 2; blk = (it - 16) & 3; } else { g = 2; r = it - 32; blk = 0; }
}
__device__ __forceinline__ void attn_unit(LAS unsigned char* lds, bf16_t* proj, bf16_t* og, float* lse, int unit) {
    const int tid = threadIdx.x, lane = tid & 63, w = __builtin_amdgcn_readfirstlane(tid >> 6), l16 = lane & 15, fq = lane >> 4, tq = l16 >> 2, tp = l16 & 3;
    const int b = unit >> 3, h = unit & 7;
    LAS unsigned char* KI = lds + AT_KI; LAS unsigned char* VI = lds + AT_VI;
    __syncthreads();
    for (int i = tid; i < 272 * AT_P / 4; i += 512) { ((LAS unsigned*)KI)[i] = 0u; ((LAS unsigned*)VI)[i] = 0u; }
    const int qi = 16 * w + l16;
    u32x4 kreg[2], vreg[2]; bf16x8 Qn[2];
#define ATT_LOAD(it_) do { int g_, r_, blk_; attn_decode_it((it_), g_, r_, blk_); const int dil_ = 1 << (2 * g_); \
        _Pragma("unroll") for (int i_ = 0; i_ < 2; ++i_) { const int p_ = tid + 512 * i_, kc_ = p_ >> 3, pc_ = p_ & 7; \
            const bf16_t* base_ = proj + ((size_t)b * SEQ + (128 * blk_ + kc_) * dil_ + r_) * DIN + g_ * 512 + h * 64 + 8 * pc_; \
            kreg[i_] = *(const u32x4*)(base_ + KA_OFF); vreg[i_] = *(const u32x4*)(base_ + VA_OFF); } \
        { const bf16_t* qp_ = proj + ((size_t)b * SEQ + (128 * blk_ + qi) * dil_ + r_) * DIN + QA_OFF + g_ * 512 + h * 64 + 8 * fq; \
          Qn[0] = *(const bf16x8*)qp_; Qn[1] = *(const bf16x8*)(qp_ + 32); } } while (0)
    ATT_LOAD(0);
#pragma unroll 1
    for (int it = 0; it < 48; ++it) {
        int g, r, blk; attn_decode_it(it, g, r, blk); const int dil = 1 << (2 * g);
        const int par = it & 1;
        if (it == 32) { asm volatile("s_waitcnt vmcnt(0)" ::: "memory"); __syncthreads(); }
        LDS_BARRIER();
#pragma unroll
        for (int i = 0; i < 2; ++i) { const int p = tid + 512 * i, kc = p >> 3, pc = p & 7;
            *(LAS u32x4*)(KI + (par * 128 + kc) * AT_P + pc * 16) = kreg[i]; *(LAS u32x4*)(VI + (par * 128 + kc) * AT_P + pc * 16) = vreg[i]; }
        bf16x8 Qf[2]; Qf[0] = Qn[0]; Qf[1] = Qn[1];
        const int tokq = (128 * blk + qi) * dil + r; const size_t rowq = (size_t)b * SEQ + tokq;
        float l0 = 0.f, l1 = 0.f; u32x2 c0[4], c1[4];
#pragma unroll
        for (int et = 0; et < 4; ++et) { c0[et] = (u32x2){0u, 0u}; c1[et] = (u32x2){0u, 0u}; }
        SCHED_BAR();
        if (g == 2) {
            l0 = lse[((size_t)0 * 128 + unit) * SEQ + tokq]; l1 = lse[((size_t)1 * 128 + unit) * SEQ + tokq];
            const bf16_t* o0p = og + ((size_t)0 * MP + rowq) * 512 + h * 64 + 4 * fq; const bf16_t* o1p = og + ((size_t)1 * MP + rowq) * 512 + h * 64 + 4 * fq;
#pragma unroll
            for (int et = 0; et < 4; ++et) { c0[et] = *(const u32x2*)(o0p + 16 * et); c1[et] = *(const u32x2*)(o1p + 16 * et); }
        }
        SCHED_BAR();
        if (it + 1 < 48) ATT_LOAD(it + 1);
        SCHED_BAR();
        LDS_BARRIER();
#define ATT_TROW(T_) (((T_) < 8) ? ((1 - par) * 128 + 16 * (T_)) : ((T_) < 16) ? (par * 128 + 16 * ((T_) - 8)) : 256)
        f32x4 S[10]; float mx = -1e30f;
#pragma unroll
        for (int hb = 0; hb < 2; ++hb) { bf16x8 F[10];
#pragma unroll
            for (int k5 = 0; k5 < 5; ++k5) { if (5 * hb + k5 < 9) { const int tr0 = ATT_TROW(w + 5 * hb + k5);
#pragma unroll
                for (int ks = 0; ks < 2; ++ks) F[2 * k5 + ks] = *(const LAS bf16x8*)(KI + (tr0 + l16) * AT_P + (32 * ks + 8 * fq) * 2); } }
            SCHED_BAR();
#pragma unroll
            for (int k5 = 0; k5 < 5; ++k5) if (5 * hb + k5 < 9) S[5 * hb + k5] = __builtin_amdgcn_mfma_f32_16x16x32_bf16(F[2 * k5], Qf[0], (f32x4){0.f, 0.f, 0.f, 0.f}, 0, 0, 0);
#pragma unroll
            for (int k5 = 0; k5 < 5; ++k5) if (5 * hb + k5 < 9) S[5 * hb + k5] = __builtin_amdgcn_mfma_f32_16x16x32_bf16(F[2 * k5 + 1], Qf[1], S[5 * hb + k5], 0, 0, 0);
            SCHED_BAR(); }
#pragma unroll
        for (int kt = 0; kt < 10; ++kt) {
            if (kt == 9) { S[kt] = (f32x4){-1e30f, -1e30f, -1e30f, -1e30f}; }
            else {
                const bool tile_ok = (w + kt >= 8) || (blk > 0);
#pragma unroll
                for (int jj = 0; jj < 4; ++jj) {
                    const bool valid = (kt == 0) ? (tile_ok && (4 * fq + jj >= l16)) : (kt == 8) ? (tile_ok && (4 * fq + jj <= l16)) : tile_ok;
                    const float sv = valid ? S[kt][jj] : -1e30f; S[kt][jj] = sv; mx = fmaxf(mx, sv); } } }
        mx = fmaxf(mx, __shfl_xor(mx, 16)); mx = fmaxf(mx, __shfl_xor(mx, 32));
        float l = 0.f;
#pragma unroll
        for (int kt = 0; kt < 10; ++kt)
#pragma unroll
            for (int jj = 0; jj < 4; ++jj) { const float pv = __expf(S[kt][jj] - mx); S[kt][jj] = pv; l += pv; }
        l += __shfl_xor(l, 16); l += __shfl_xor(l, 32);
        f32x4 O[4];
#pragma unroll
        for (int et = 0; et < 4; ++et) O[et] = (f32x4){0.f, 0.f, 0.f, 0.f};
#pragma unroll
        for (int s5 = 0; s5 < 5; ++s5) { const bf16x8 Pf = pack8(S[2 * s5], S[2 * s5 + 1]); s16x4 tv[8];
            const int ra = ATT_TROW(w + 2 * s5), rb2 = ATT_TROW(w + 2 * s5 + 1);
#pragma unroll
            for (int et = 0; et < 4; ++et) { tv[2 * et] = trr(VI + (ra + 4 * fq + tq) * AT_P + (16 * et + 4 * tp) * 2);
                tv[2 * et + 1] = trr(VI + (rb2 + 4 * fq + tq) * AT_P + (16 * et + 4 * tp) * 2); }
            SCHED_BAR();
#pragma unroll
            for (int et = 0; et < 4; ++et) O[et] = __builtin_amdgcn_mfma_f32_16x16x32_bf16(cat8(tv[2 * et], tv[2 * et + 1]), Pf, O[et], 0, 0, 0);
            SCHED_BAR(); }
#undef ATT_TROW
        const float inv = 1.0f / l, lsv = mx + __logf(l);
        if (g < 2) {
            bf16_t* ogp = og + ((size_t)g * MP + rowq) * 512 + h * 64 + 4 * fq;
#pragma unroll
            for (int et = 0; et < 4; ++et) { u32x2 wv; wv.x = cvt_pk_bf16(O[et][0] * inv, O[et][1] * inv); wv.y = cvt_pk_bf16(O[et][2] * inv, O[et][3] * inv); *(u32x2*)(ogp + 16 * et) = wv; }
            if (fq == 0) lse[((size_t)g * 128 + unit) * SEQ + tokq] = lsv;
        } else {
            const float mm = fmaxf(lsv, fmaxf(l0, l1)); float w0 = __expf(l0 - mm), w1 = __expf(l1 - mm), w2 = __expf(lsv - mm); const float iv = 1.0f / (w0 + w1 + w2);
            w0 *= iv; w1 *= iv; w2 *= iv * inv;
            bf16_t* dst = proj + rowq * DIN + QA_OFF + h * 64 + 4 * fq;
#pragma unroll
            for (int et = 0; et < 4; ++et) { const u32x2 a0 = c0[et], a1 = c1[et];
                const float r0 = bflo(a0.x) * w0 + bflo(a1.x) * w1 + O[et][0] * w2, r1 = bfhi(a0.x) * w0 + bfhi(a1.x) * w1 + O[et][1] * w2;
                const float r2 = bflo(a0.y) * w0 + bflo(a1.y) * w1 + O[et][2] * w2, r3 = bfhi(a0.y) * w0 + bfhi(a1.y) * w1 + O[et][3] * w2;
                u32x2 wv; wv.x = cvt_pk_bf16(r0, r1); wv.y = cvt_pk_bf16(r2, r3); *(u32x2*)(dst + 16 * et) = wv; }
        }
    }
#undef ATT_LOAD
}

__device__ __forceinline__ float wave_max(float v) { for (int o = 1; o < 64; o <<= 1) v = fmaxf(v, __shfl_xor(v, o)); return v; }
__device__ __forceinline__ float wave_sum(float v) { for (int o = 1; o < 64; o <<= 1) v += __shfl_xor(v, o); return v; }
__device__ __forceinline__ void sample_attn_task(LAS float* qs, const Ptrs& P, bf16_t* proj, const float* kvnew, int task, int lane) {
    const int b = task >> 3, h = task & 7; const size_t row = (size_t)MPROMPT + b;
    float M = -1e30f, num = 0.f, den = 0.f;
#pragma unroll 1
    for (int g = 0; g < 3; ++g) {
        const int wb = 128 << (2 * g), dil = 1 << (2 * g); const float* cache = (g == 0) ? P.in[2] : (g == 1) ? P.in[3] : P.in[4];
        const float* kn = kvnew + (size_t)b * 3072 + g * 512 + h * 64;
        const float* cb = cache + (size_t)b * wb * 1024 + h * 64;
        { const unsigned short qv = proj[row * DIN + QA_OFF + g * 512 + h * 64 + lane]; qs[lane] = __uint_as_float((unsigned)qv << 16); }
        asm volatile("s_waitcnt lgkmcnt(0)" ::: "memory");
        float sc[3];
#pragma unroll
        for (int rnd = 0; rnd < 3; ++rnd) { const int j = lane + 64 * rnd; float s = -1e30f;
            if (j <= 128) { const float* kp = (j == 0) ? kn : cb + (size_t)(wb - dil * j) * 1024;
                s = 0.f;
#pragma unroll
                for (int d4 = 0; d4 < 16; ++d4) { const f32x4 kv = *(const f32x4*)(kp + 4 * d4); const f32x4 qv = *(const LAS f32x4*)(qs + 4 * d4);
                    s += (kv[0] * qv[0] + kv[1] * qv[1]) + (kv[2] * qv[2] + kv[3] * qv[3]); } }
            sc[rnd] = s; }
        const float mx = wave_max(fmaxf(sc[0], fmaxf(sc[1], sc[2])));
        float pr[3]; float l = 0.f;
#pragma unroll
        for (int rnd = 0; rnd < 3; ++rnd) { pr[rnd] = __expf(sc[rnd] - mx); l += pr[rnd]; }
        l = wave_sum(l);
        float o = __shfl(pr[0], 0) * kn[1536 + lane];
#pragma unroll 1
        for (int j0 = 1; j0 <= 128; j0 += 16) { float vv[16];
#pragma unroll
            for (int k = 0; k < 16; ++k) vv[k] = cb[(size_t)(wb - dil * (j0 + k)) * 1024 + 512 + lane];
#pragma unroll
            for (int k = 0; k < 16; ++k) { const int j = j0 + k; const float pj = __shfl(j < 64 ? pr[0] : j < 128 ? pr[1] : pr[2], j & 63); o += pj * vv[k]; } }
        const float og = o / l, ls = mx + __logf(l);
        const float Mn = fmaxf(M, ls), sa = __expf(M - Mn), sb = __expf(ls - Mn);
        num = num * sa + og * sb; den = den * sa + sb; M = Mn;
    }
    proj[row * DIN + QA_OFF + h * 64 + lane] = (bf16_t)(cvt_pk_bf16(num / den, 0.f) & 0xffffu);
}
__device__ __forceinline__ void sample_ret_unit(LAS unsigned char* lds, const Ptrs& P, bf16_t* proj, int unit) {
    const int tid = threadIdx.x, b = unit >> 2, h = unit & 3; const size_t row = (size_t)MPROMPT + b;
    const float gam = 1.0f - exp2f(-5.0f - (float)h);
    LAS float* qk = (LAS float*)lds;
    LAS float* red = (LAS float*)(lds + 4096);
    LAS float* wsum = (LAS float*)(lds + 4096 + 8192);
    __syncthreads();
    { const int i = tid & 255; const int off = (tid < 256) ? QR_OFF : KR_OFF; qk[tid] = __uint_as_float((unsigned)proj[row * DIN + off + 256 * h + i] << 16); }
    const int e4 = tid & 127, dg = tid >> 7;
    const u32x2 vw = *(const u32x2*)(proj + row * DIN + VR_OFF + 512 * h + 4 * e4);
    const f32x4 vv = {bflo(vw.x), bfhi(vw.x), bflo(vw.y), bfhi(vw.y)};
    __syncthreads();
    const float* s0 = P.in[5] + (size_t)unit * 256 * 512; float* s1 = P.out + OFF_RS + (size_t)unit * 256 * 512;
    f32x4 oacc = {0.f, 0.f, 0.f, 0.f};
#pragma unroll 4
    for (int it = 0; it < 64; ++it) { const int d = dg + 4 * it; const float kd = qk[256 + d], qd = qk[d];
        const f32x4 sn = *(const f32x4*)(s0 + (size_t)d * 512 + 4 * e4) * gam + vv * kd;
        *(f32x4*)(s1 + (size_t)d * 512 + 4 * e4) = sn; oacc += sn * qd; }
    *(LAS f32x4*)(red + dg * 512 + 4 * e4) = oacc;
    __syncthreads();
    const float o = (red[tid] + red[512 + tid]) + (red[1024 + tid] + red[1536 + tid]);
    const float ps = wave_sum(o * o);
    if ((tid & 63) == 0) wsum[tid >> 6] = ps;
    __syncthreads();
    float tot = 0.f;
#pragma unroll
    for (int i = 0; i < 8; ++i) tot += wsum[i];
    const float rs = rsqrtf(tot * (1.0f / 512.0f) + EPS);
    const float gv = __uint_as_float((unsigned)proj[row * DIN + GR_OFF + 512 * h + tid] << 16);
    proj[row * DIN + VR_OFF + 512 * h + tid] = (bf16_t)(cvt_pk_bf16(o * rs * gv, 0.f) & 0xffffu);
}


#define XB_TMO      128
#define XB_XCNT(j)  (256  + 64 * (j))
#define XB_XSUB(j)  (1280 + 64 * (j))
#define XB_XGEN(j)  (2304 + 64 * (j))
#define XB_TOP      3328
#define XB_TOPGEN   3392
#define XB_SPIN_CAP (1u << 18)
__device__ __forceinline__ unsigned xb_ld(unsigned* p)              { return __hip_atomic_load(p, __ATOMIC_RELAXED, __HIP_MEMORY_SCOPE_AGENT); }
__device__ __forceinline__ unsigned xb_add(unsigned* p, unsigned v) { return __hip_atomic_fetch_add(p, v, __ATOMIC_RELAXED, __HIP_MEMORY_SCOPE_AGENT); }
__device__ __forceinline__ unsigned xb_xcc_id() { return (unsigned)__builtin_amdgcn_s_getreg((3 << 11) | 20) & 0xFu; }
#define XB_SPIN(cond, bar) do { unsigned _sp = 0; while (cond) { __builtin_amdgcn_s_sleep(1); \
    if ((++_sp & 255u) == 0u) { if (xb_ld(&(bar)[XB_TMO])) break; if (_sp > XB_SPIN_CAP) { atomicAdd(&(bar)[XB_TMO], 1u); break; } } } } while (0)
struct XcdBarrier { unsigned* bar; unsigned x; volatile LAS unsigned* st; };
__device__ __forceinline__ XcdBarrier xcd_barrier_post(unsigned* bar, volatile LAS unsigned* st) {
    XcdBarrier b; b.bar = bar; b.x = xb_xcc_id(); b.st = st;
    if (threadIdx.x == 0) (void)xb_add(&bar[XB_XCNT(b.x)], 1u);
    return b;
}
__device__ __forceinline__ void xcd_barrier_complete(unsigned* bar, unsigned x, unsigned& nloc, unsigned& nx) {
    const unsigned G = gridDim.x * gridDim.y * gridDim.z;
    unsigned sum, cnt, mine, sp = 0u;
    for (;;) {
        sum = 0u; cnt = 0u; mine = 0u;
#pragma unroll
        for (unsigned j = 0; j < 16; ++j) { const unsigned c = xb_ld(&bar[XB_XCNT(j)]); sum += c; cnt += (c > 0u) ? 1u : 0u; mine = (j == x) ? c : mine; }
        if (sum == G) break;
        __builtin_amdgcn_s_sleep(1);
        if ((++sp & 255u) == 0u) { if (xb_ld(&bar[XB_TMO])) break; if (sp > XB_SPIN_CAP) { atomicAdd(&bar[XB_TMO], 1u); break; } }
    }
    nloc = mine > 0u ? mine : 1u; nx = cnt > 0u ? cnt : 1u;
}
__device__ __forceinline__ void xcd_barrier(const XcdBarrier& b) {
    asm volatile("s_waitcnt vmcnt(0)" ::: "memory");
    __syncthreads();
    if (threadIdx.x == 0) {
        unsigned* bar = b.bar;
        __builtin_amdgcn_s_waitcnt(0);
        unsigned nloc = b.st[0], nx = b.st[1];
        if (nloc == 0u) { xcd_barrier_complete(bar, b.x, nloc, nx); b.st[0] = nloc; b.st[1] = nx; }
        const unsigned old = xb_add(&bar[XB_XSUB(b.x)], 1u);
        const unsigned gen = old / nloc;
        if (old + 1u == (gen + 1u) * nloc) {
            __builtin_amdgcn_fence(__ATOMIC_RELEASE, "agent");
            asm volatile("s_waitcnt vmcnt(0)" ::: "memory");
            const unsigned og = xb_add(&bar[XB_TOP], 1u);
            const unsigned tg = og / nx;
            if (og + 1u == (tg + 1u) * nx) xb_add(&bar[XB_TOPGEN], 1u);
            else XB_SPIN(xb_ld(&bar[XB_TOPGEN]) == tg, bar);
            __builtin_amdgcn_fence(__ATOMIC_ACQUIRE, "agent");
            xb_add(&bar[XB_XGEN(b.x)], 1u);
            asm volatile("s_waitcnt vmcnt(0)" ::: "memory");
        } else {
            XB_SPIN(xb_ld(&bar[XB_XGEN(b.x)]) == gen, bar);
            __builtin_amdgcn_fence(__ATOMIC_ACQUIRE, "agent");
            asm volatile("s_waitcnt vmcnt(0)" ::: "memory");
        }
    }
    __syncthreads();
}

__global__ void __launch_bounds__(512, 2) fwd_megakernel(Ptrs P) {
    extern __shared__ __attribute__((aligned(16))) unsigned char lds_raw[];
    LAS unsigned char* lds = (LAS unsigned char*)lds_raw;
    cg::grid_group grid = cg::this_grid();
    const int tid = threadIdx.x, lane = tid & 63, wave = __builtin_amdgcn_readfirstlane(tid >> 6);
    const int G = gridDim.x, bx = blockIdx.x;
    unsigned char* ws = P.ws;
    if (tid < 2) ((LAS unsigned*)(lds + 135168 + 64))[tid] = 0u;
    __syncthreads();
    const XcdBarrier xbar = xcd_barrier_post((unsigned*)(ws + WS_BAR), (volatile LAS unsigned*)(lds + 135168 + 64));
    float* SS0 = (float*)(ws + WS_SS0); float* SS1 = (float*)(ws + WS_SS1); float* SS2 = (float*)(ws + WS_SS2); float* RSS = (float*)(ws + WS_RSS);
    unsigned* CNT = (unsigned*)(ws + WS_CNT);
    float* ROPE = (float*)(ws + WS_ROPE); float* RROT = (float*)(ws + WS_RROT);
    bf16_t* W1T = (bf16_t*)(ws + WS_W1T); bf16_t* W2T = (bf16_t*)(ws + WS_W2T); bf16_t* WINT = (bf16_t*)(ws + WS_WINT); bf16_t* WPAT = (bf16_t*)(ws + WS_WPAT);
    bf16_t* WPBT = (bf16_t*)(ws + WS_WPBT); bf16_t* WOT = (bf16_t*)(ws + WS_WOT); bf16_t* W3T = (bf16_t*)(ws + WS_W3T); bf16_t* W4T = (bf16_t*)(ws + WS_W4T);
    bf16_t* XB = (bf16_t*)(ws + WS_XB); float* KVNEW = (float*)(ws + WS_KVNEW); bf16_t* PROJ = (bf16_t*)(ws + WS_PROJ); bf16_t* ACT = (bf16_t*)(ws + WS_ACT); bf16_t* X2B = (bf16_t*)(ws + WS_X2B);

    {
        LAS float* scr = (LAS float*)(lds + wave * 16896);
        const int gw = bx * 8 + wave, NGW = G * 8;
        constexpr int I1 = 16 * 88, I2 = 44 * 16, I3 = 16 * 200, I4 = 8 * 16, I5 = 32 * 16, I6 = 16 * 16;
        constexpr int NITEMS = 2 * I1 + 2 * I2 + I3 + I4 + I5 + I6;
        for (int it = gw; it < NITEMS; it += NGW) {
            int r = it;
            if (r < I3) { p0_transpose_item(P.in[10], 1024, DIN, WINT, 2, P.in[9], scr, r, 200, lane); continue; } r -= I3;
            if (r < I1) { p0_transpose_item(P.in[7], 1024, 5632, W1T, 3, P.in[6], scr, r, 88, lane); continue; } r -= I1;
            if (r < I1) { p0_transpose_item(P.in[17], 1024, 5632, W3T, 3, P.in[16], scr, r, 88, lane); continue; } r -= I1;
            if (r < I2) { p0_transpose_item(P.in[8], DFF, 1024, W2T, 2, nullptr, scr, r, 16, lane); continue; } r -= I2;
            if (r < I2) { p0_transpose_item(P.in[18], DFF, 1024, W4T, 2, nullptr, scr, r, 16, lane); continue; } r -= I2;
            if (r < I4) { p0_transpose_item(P.in[13], 512, 1024, WPAT, 2, nullptr, scr, r, 16, lane); continue; } r -= I4;
            if (r < I5) { p0_transpose_item(P.in[14], 2048, 1024, WPBT, 2, nullptr, scr, r, 16, lane); continue; } r -= I5;
            p0_transpose_item(P.in[15], 1024, 1024, WOT, 2, nullptr, scr, r, 16, lane);
        }
        for (int row0 = gw; row0 < MP; row0 += 2 * NGW) {
            f32x4 v[2][4]; bool okr[2]; int rws[2];
#pragma unroll
            for (int q = 0; q < 2; ++q) { const int row = row0 + q * NGW; rws[q] = row; okr[q] = row < MREAL;
                const f32x4* xr = (const f32x4*)xin_row(P, okr[q] ? row : 0) + lane;
#pragma unroll
                for (int j = 0; j < 4; ++j) v[q][j] = xr[64 * j]; }
            SCHED_BAR();
#pragma unroll
            for (int q = 0; q < 2; ++q) { const int row = rws[q];
                if (row < MP) {
                    unsigned long long* o8 = (unsigned long long*)(XB + (size_t)row * DM) + lane;
                    if (okr[q]) { float sq = 0.f;
#pragma unroll
                        for (int j = 0; j < 4; ++j) sq += (v[q][j][0] * v[q][j][0] + v[q][j][1] * v[q][j][1]) + (v[q][j][2] * v[q][j][2] + v[q][j][3] * v[q][j][3]);
                        sq = wave_sum(sq);
#pragma unroll
                        for (int j = 0; j < 4; ++j) o8[64 * j] = (unsigned long long)cvt_pk_bf16(v[q][j][0], v[q][j][1]) | ((unsigned long long)cvt_pk_bf16(v[q][j][2], v[q][j][3]) << 32);
                        if (lane == 0) SS0[row] = sq;
                    } else {
#pragma unroll
                        for (int j = 0; j < 4; ++j) o8[64 * j] = 0ull;
                    }
                } }
        }
        const int gt = bx * 512 + tid, NGT = G * 512;
        for (int i = gt; i < 2049 * 136; i += NGT) { const int p = i / 136, f = i % 136; const float pos = (p < 2048) ? (float)p : 16384.0f;
            double inv; float* dst;
            if (f < 8) { inv = my_exp(-(double)f / 8.0 * 13.122363377404328); dst = ROPE + ((size_t)p * 8 + f) * 2; }
            else { const int q = f - 8; inv = my_exp(-(double)q / 127.0 * 9.210340371976184); dst = RROT + ((size_t)p * 128 + q) * 2; }
            const float ang = pos * (float)inv; double s, c; my_sincos((double)ang, s, c); dst[0] = (float)c; dst[1] = (float)s; }
    }
    grid.sync();

    pg8::StaticOrder S;
    { pg8::Gemm g{XB, W1T, DM, MP, 5632, 1024, 0}; S.init(MPROMPT, 5632, G, bx); EpiSwiglu E{ACT, SS0}; pg8::gemm_phase(lds, g, S, E); skinny_phase(lds, g, E, G, bx); }
    xcd_barrier(xbar);
    { pg8::Gemm g{ACT, W2T, DFF, MP, 1024, DFF, 1}; S.init(MPROMPT, 1024, G, bx); EpiResid<0> E{P, XB, SS1}; pg8::gemm_phase(lds, g, S, E); skinny_phase(lds, g, E, G, bx); }
    xcd_barrier(xbar);
    { pg8::Gemm g{XB, WINT, DM, MP, DIN, 1024, 0}; S.init(MPROMPT, DIN, G, bx); EpiProj E{P, PROJ, SS1, ROPE, RROT, KVNEW}; pg8::gemm_phase(lds, g, S, E); skinny_phase(lds, g, E, G, bx); }
    xcd_barrier(xbar);
    {
        if (G == 256) {
            const int xcd = bx & 7, slot = bx >> 3;
            for (int rnd = 0; rnd < 2; ++rnd) ret_unit(lds, PROJ, P.out, RSS, CNT, rnd * 256 + ((xcd * 4 + (slot >> 3)) * 8 + (slot & 7)), true);
        } else {
            for (int u = bx; u < 512; u += G) ret_unit(lds, PROJ, P.out, RSS, CNT, u, false);
        }
        for (int u = bx; u < 128; u += G) attn_unit(lds, PROJ, (bf16_t*)(ws + WS_OG), (float*)(ws + WS_LSE), u);
        const int rb = G - 1 - bx;
        for (int u = rb; u < 128; u += G) sample_ret_unit(lds, P, PROJ, u);
        __syncthreads();
        for (int t = rb * 8 + wave; t < 256; t += G * 8) sample_attn_task((LAS float*)(lds + 16384 + wave * 256), P, PROJ, KVNEW, t, lane);
        { const int ncw = (G > 128) ? (G - 128) : G;
          if (rb < ncw) {
            const size_t gt = (size_t)rb * 512 + tid, NGT = (size_t)ncw * 512;
#pragma unroll 1
            for (int g = 0; g < 3; ++g) { const int lw = 7 + 2 * g, wb = 1 << lw;
                const f32x4* src = (const f32x4*)(g == 0 ? P.in[2] : g == 1 ? P.in[3] : P.in[4]); f32x4* dst = (f32x4*)(P.out + (g == 0 ? OFF_KVS0 : g == 1 ? OFF_KVS1 : OFF_KVS2));
                const size_t total = (size_t)NSAMP << (lw + 8);
                for (size_t i0 = gt; i0 < total; i0 += 8 * NGT) {
                    f32x4 v[8];
#pragma unroll
                    for (int k = 0; k < 8; ++k) { const size_t i = i0 + (size_t)k * NGT;
                        if (i < total) { const int rowi = (int)(i >> 8) & (wb - 1);
                            if (rowi < wb - 1) v[k] = __builtin_nontemporal_load(src + i + 256);
                            else { const int bb = (int)(i >> (lw + 8)), c4 = (int)(i & 255), sx = c4 >> 7, hh = (c4 >> 4) & 7, d4 = c4 & 15;
                                v[k] = *(const f32x4*)(KVNEW + (size_t)bb * 3072 + sx * 1536 + g * 512 + hh * 64 + d4 * 4); } } }
#pragma unroll
                    for (int k = 0; k < 8; ++k) { const size_t i = i0 + (size_t)k * NGT; if (i < total) __builtin_nontemporal_store(v[k], dst + i); }
                } } } }
    }
    xcd_barrier(xbar);
    { pg8::Gemm g{PROJ + QA_OFF, WPAT, DIN, MP, 1024, 512, 0}; S.init(MPROMPT, 1024, G, bx); EpiGate1 E{PROJ}; pg8::gemm_phase(lds, g, S, E); skinny_phase(lds, g, E, G, bx); }
    { pg8::Gemm g{PROJ + VR_OFF, WPBT, DIN, MP, 1024, 2048, 0}; S.init(MPROMPT, 1024, G, bx); EpiGate2 E{PROJ, XB}; pg8::gemm_phase(lds, g, S, E); skinny_phase(lds, g, E, G, bx); }
    xcd_barrier(xbar);
    { pg8::Gemm g{XB, WOT, DM, MP, 1024, 1024, 0}; S.init(MPROMPT, 1024, G, bx); EpiResid<1> E{P, X2B, SS2}; pg8::gemm_phase(lds, g, S, E); skinny_phase(lds, g, E, G, bx); }
    xcd_barrier(xbar);
    { pg8::Gemm g{X2B, W3T, DM, MP, 5632, 1024, 0}; S.init(MPROMPT, 5632, G, bx); EpiSwiglu E{ACT, SS2}; pg8::gemm_phase(lds, g, S, E); skinny_phase(lds, g, E, G, bx); }
    xcd_barrier(xbar);
    { pg8::Gemm g{ACT, W4T, DFF, MP, 1024, DFF, 1}; S.init(MPROMPT, 1024, G, bx); EpiResid<2> E{P, nullptr, nullptr}; pg8::gemm_phase(lds, g, S, E); skinny_phase(lds, g, E, G, bx); }
}

extern "C" void kernel_launch(void* const* d_in, const int* in_sizes, int n_in, void* d_out, int out_size, void* d_ws, size_t ws_size, hipStream_t stream) {
    static int grid = 0;
    if (grid == 0) {
        int dev = 0, cus = 0, per_cu = 0;
        hipGetDevice(&dev);
        hipDeviceGetAttribute(&cus, hipDeviceAttributeMultiprocessorCount, dev);
        hipFuncSetAttribute((const void*)fwd_megakernel, hipFuncAttributeMaxDynamicSharedMemorySize, LDS_BYTES);
        hipOccupancyMaxActiveBlocksPerMultiprocessor(&per_cu, (const void*)fwd_megakernel, 512, LDS_BYTES);
        if (per_cu < 1) { fprintf(stderr, "kernel_launch: occupancy query says %d blocks/CU\n", per_cu); per_cu = 1; }
        grid = cus * per_cu; if (grid > 256) grid = 256; grid &= ~7;
        if (n_in != 19 || ws_size < WS_END) fprintf(stderr, "kernel_launch: unexpected n_in %d / ws_size %zu (need %zu)\n", n_in, ws_size, (size_t)WS_END);
    }
    hipMemsetAsync(d_ws, 0, CTL_BYTES, stream);
    Ptrs p{};
    for (int i = 0; i < 19; ++i) p.in[i] = (const float*)d_in[i];
    p.out = (float*)d_out; p.ws = (unsigned char*)d_ws;
    void* args[] = {&p};
    hipError_t e = hipLaunchCooperativeKernel((const void*)fwd_megakernel, dim3(grid), dim3(512), args, LDS_BYTES, stream);
    if (e != hipSuccess) fprintf(stderr, "cooperative launch failed: %s (grid %d)\n", hipGetErrorString(e), grid);
}
```
